# Optimizing an MI355X kernel written in HIP

```python
import jax, jax.numpy as jnp
from jax import lax
import numpy as np

D_MODEL = 1024
BATCH = 4
SEQ = 8192
DEPTH = 2

CHUNK = 64
N_MIXERS = 2
N_FOX = (DEPTH + 1) // 2
N_SGU = DEPTH // 2
FOX_HEADS = 16
FOX_HEAD_DIM = D_MODEL // FOX_HEADS
Q_BLOCK = 128
SGU_WIDTH = 2 * D_MODEL
SGU_GROUPS = 8
SGU_GROUP_DIM = SGU_WIDTH // SGU_GROUPS
SGU_BLOCK = 128
D_FF = 2816
CONV_WIDTH = 3
EPS = 1e-6

kernel_name = "fox_gmlp_convffn_adaln_hybrid"


def rmsnorm(x, g):
    xf = x.astype(jnp.float32)
    y = xf * lax.rsqrt(jnp.mean(xf * xf, axis=-1, keepdims=True) + EPS)
    return (y * g.astype(jnp.float32)).astype(x.dtype)


def layernorm(x, g, b):
    xf = x.astype(jnp.float32)
    mu = jnp.mean(xf, axis=-1, keepdims=True)
    var = jnp.mean(jnp.square(xf - mu), axis=-1, keepdims=True)
    y = (xf - mu) * lax.rsqrt(var + EPS)
    return (y * g.astype(jnp.float32) + b.astype(jnp.float32)).astype(x.dtype)


def modulate(h, shift, scale):
    return h * (1 + scale[:, None, :]) + shift[:, None, :]


def forgetting_attention(h, w_in, b_f, q_gain, k_gain, w_out):
    B, S, D = h.shape
    H, Dh = FOX_HEADS, FOX_HEAD_DIM
    proj = h @ w_in
    q, k, v, o, fl = jnp.split(proj, [D, 2 * D, 3 * D, 4 * D], axis=-1)
    q = rmsnorm(q.reshape(B, S, H, Dh), q_gain)
    k = rmsnorm(k.reshape(B, S, H, Dh), k_gain)
    v = v.reshape(B, S, H, Dh)
    logf = jax.nn.log_sigmoid((fl + b_f).astype(jnp.float32))
    F = jnp.cumsum(logf, axis=1).transpose(0, 2, 1)
    scale = Dh ** -0.5
    outs = []
    for qb in range(S // Q_BLOCK):
        q0, q1 = qb * Q_BLOCK, (qb + 1) * Q_BLOCK
        logits = jnp.einsum('bqhd,bkhd->bhqk', q[:, q0:q1], k[:, :q1]).astype(jnp.float32) * scale
        decay = F[:, :, q0:q1, None] - F[:, :, None, :q1]
        qpos = jnp.arange(q0, q1)[:, None]
        kpos = jnp.arange(q1)[None, :]
        logits = jnp.where(kpos <= qpos, logits + decay, -jnp.inf)
        p = jax.nn.softmax(logits, axis=-1).astype(v.dtype)
        outs.append(jnp.einsum('bhqk,bkhd->bqhd', p, v[:, :q1]))
    att = jnp.concatenate(outs, axis=1).reshape(B, S, D)
    return (att * jax.nn.sigmoid(o)) @ w_out


def spatial_gating_mlp(h, w_in, b_in, v_gain, v_bias, w_s, b_s, w_out):
    B, S, _ = h.shape
    z = jax.nn.gelu(h @ w_in + b_in)
    u, v = jnp.split(z, 2, axis=-1)
    v = layernorm(v, v_gain, v_bias)
    n = S // SGU_BLOCK
    v = v.reshape(B, n, SGU_BLOCK, SGU_GROUPS, SGU_GROUP_DIM)
    t = jnp.arange(SGU_BLOCK)
    mask = (t[None, :] // CHUNK) <= (t[:, None] // CHUNK)
    ws = jnp.where(mask[None], w_s, 0)
    mixed = jnp.einsum('gts,bnsgc->bntgc', ws, v) + b_s.T[None, None, :, :, None]
    y = u * mixed.reshape(B, S, SGU_WIDTH)
    return y @ w_out


def conv_gated_ffn(h, w_up, conv_w, conv_b, w_down):
    S = h.shape[1]
    a = h @ w_up
    ap = jnp.pad(a, ((0, 0), (CONV_WIDTH - 1, 0), (0, 0)))
    acc = ap[:, 0:S] * conv_w[0]
    for j in range(1, CONV_WIDTH):
        acc = acc + ap[:, j:j + S] * conv_w[j]
    a = acc + conv_b
    g, val = jnp.split(a, 2, axis=-1)
    return (jax.nn.silu(g) * val) @ w_down


def setup_inputs(seed: int = 0) -> dict:
    key = jax.random.key(seed)
    ks = jax.random.split(key, 24)
    D = D_MODEL
    nrm = jax.random.normal
    f32 = jnp.float32
    return {
        "x": nrm(ks[0], (BATCH, SEQ, D), f32),
        "c": nrm(ks[1], (BATCH, D), f32),
        "fox_w_in": nrm(ks[2], (N_FOX, D, 4 * D + FOX_HEADS), f32) * D ** -0.5,
        "fox_b_f": 3.0 + 0.5 * nrm(ks[3], (N_FOX, FOX_HEADS), f32),
        "fox_q_gain": 1.0 + 0.02 * nrm(ks[4], (N_FOX, FOX_HEAD_DIM), f32),
        "fox_k_gain": 1.0 + 0.02 * nrm(ks[5], (N_FOX, FOX_HEAD_DIM), f32),
        "fox_w_out": nrm(ks[6], (N_FOX, D, D), f32) * D ** -0.5,
        "sgu_w_in": nrm(ks[7], (N_SGU, D, 2 * SGU_WIDTH), f32) * D ** -0.5,
        "sgu_b_in": 0.02 * nrm(ks[8], (N_SGU, 2 * SGU_WIDTH), f32),
        "sgu_v_gain": 1.0 + 0.02 * nrm(ks[9], (N_SGU, SGU_WIDTH), f32),
        "sgu_v_bias": 0.02 * nrm(ks[10], (N_SGU, SGU_WIDTH), f32),
        "sgu_w_s": nrm(ks[11], (N_SGU, SGU_GROUPS, SGU_BLOCK, SGU_BLOCK), f32) * SGU_BLOCK ** -0.5,
        "sgu_b_s": 1.0 + 0.1 * nrm(ks[12], (N_SGU, SGU_GROUPS, SGU_BLOCK), f32),
        "sgu_w_out": nrm(ks[13], (N_SGU, SGU_WIDTH, D), f32) * SGU_WIDTH ** -0.5,
        "ffn_w_up": nrm(ks[14], (DEPTH, D, 2 * D_FF), f32) * D ** -0.5,
        "ffn_conv_w": nrm(ks[15], (DEPTH, CONV_WIDTH, 2 * D_FF), f32) * CONV_WIDTH ** -0.5,
        "ffn_conv_b": 0.02 * nrm(ks[16], (DEPTH, 2 * D_FF), f32),
        "ffn_w_down": nrm(ks[17], (DEPTH, D_FF, D), f32) * D_FF ** -0.5,
        "ada_w": nrm(ks[18], (DEPTH, D, 6 * D), f32) * (0.5 * D ** -0.5),
        "ada_b": 0.02 * nrm(ks[19], (DEPTH, 6 * D), f32),
        "norm1_g": 1.0 + 0.02 * nrm(ks[20], (DEPTH, D), f32),
        "norm2_g": 1.0 + 0.02 * nrm(ks[21], (DEPTH, D), f32),
        "final_g": 1.0 + 0.02 * nrm(ks[22], (D,), f32),
    }


def reference(x, c, fox_w_in, fox_b_f, fox_q_gain, fox_k_gain, fox_w_out,
              sgu_w_in, sgu_b_in, sgu_v_gain, sgu_v_bias, sgu_w_s, sgu_b_s, sgu_w_out,
              ffn_w_up, ffn_conv_w, ffn_conv_b, ffn_w_down,
              ada_w, ada_b, norm1_g, norm2_g, final_g):
    c_act = jax.nn.silu(c)
    for i in range(DEPTH):
        mod = c_act @ ada_w[i] + ada_b[i]
        sh1, sc1, g1, sh2, sc2, g2 = jnp.split(mod, 6, axis=-1)
        h = modulate(rmsnorm(x, norm1_g[i]), sh1, sc1)
        j = i // N_MIXERS
        if i % N_MIXERS == 0:
            y = forgetting_attention(h, fox_w_in[j], fox_b_f[j], fox_q_gain[j],
                                     fox_k_gain[j], fox_w_out[j])
        else:
            y = spatial_gating_mlp(h, sgu_w_in[j], sgu_b_in[j], sgu_v_gain[j],
                                   sgu_v_bias[j], sgu_w_s[j], sgu_b_s[j], sgu_w_out[j])
        x = x + g1[:, None, :] * y
        h = modulate(rmsnorm(x, norm2_g[i]), sh2, sc2)
        x = x + g2[:, None, :] * conv_gated_ffn(h, ffn_w_up[i], ffn_conv_w[i],
                                                ffn_conv_b[i], ffn_w_down[i])
    return rmsnorm(x, final_g)
```

```cpp
#include <hip/hip_runtime.h>
#include <hip/hip_cooperative_groups.h>
#include <cstdio>
#include <cstdint>
namespace pg8 {
#define PG8_LAS __attribute__((address_space(3)))
typedef unsigned short bf16_t;
typedef short bf16x8 __attribute__((ext_vector_type(8)));
typedef float f32x4 __attribute__((ext_vector_type(4)));
typedef unsigned u32x4 __attribute__((ext_vector_type(4)));
constexpr int BM = 256, BK = 64, HALF = 128, HTB = HALF * BK * 2  , STAGE_BYTES = 8 * HTB, NXCD = 8, WGM = 8;

__host__ __device__ __forceinline__ int lds_byte(int r, int c) { const int st = (r >> 4) * 2 + (c >> 5), rr = r & 15, cc = c & 31, ob = rr * 64 + cc * 2; return st * 1024 + (ob ^ (((ob >> 9) & 1) << 5)); }
__host__ __device__ __forceinline__ void stage_rc(int b, int& R, int& C) { const int st = b / 1024, sb = b % 1024, swz = sb ^ (((sb >> 9) & 1) << 5); R = (st >> 1) * 16 + swz / 64; C = (st & 1) * 32 + (swz % 64) / 2; }
__host__ __device__ __forceinline__ int perm32(int rho) { const int n = rho >> 4, i = rho & 15; return 8 * (i >> 2) + 4 * n + (i & 3); }

struct Unit { int pm, pn; };
struct Gemm { const bf16_t* A; const bf16_t* Bt; int M, N, K; };

struct StaticOrder {
    int nM, nN, nwg, G, c;
    __host__ __device__ void init(int M, int N, int G_, int c_) { nM = M / BM; nN = N / BM; nwg = nM * nN; G = G_; c = c_; }
    __host__ __device__ bool next(int i, Unit& u) const {
        const long L = (long)i * G + c; if (L >= nwg) return false;
        int wgid = (int)L; { const int q = nwg / NXCD, r = nwg % NXCD, xcd = wgid % NXCD, off = wgid / NXCD; wgid = (xcd < r ? xcd * (q + 1) : r * (q + 1) + (xcd - r) * q) + off; }
        const int nig = WGM * nN, gid = wgid / nig, fm = gid * WGM, gsz = (nM - fm) < WGM ? (nM - fm) : WGM;
        u.pm = fm + ((wgid % nig) % gsz); u.pn = (wgid % nig) / gsz; return true;
    }
    __device__ __forceinline__ void a_ready(const Unit&) const {}
    __device__ __forceinline__ void done(const Unit&) const {}
};

__device__ __forceinline__ unsigned cvt_pk_bf16(float lo, float hi) { unsigned r; asm volatile("v_cvt_pk_bf16_f32 %0, %1, %2" : "=v"(r) : "v"(lo), "v"(hi)); return r; }
typedef _Float16 f16x2_t __attribute__((ext_vector_type(2))); typedef float f32x2c_t __attribute__((ext_vector_type(2)));
__device__ __forceinline__ unsigned pk_h2(float lo, float hi) { const f32x2c_t v = {lo, hi}; return __builtin_bit_cast(unsigned, __builtin_convertvector(v, f16x2_t)); }
__device__ __forceinline__ float h_lo(unsigned w) { return (float)__builtin_bit_cast(f16x2_t, w)[0]; }
__device__ __forceinline__ float h_hi(unsigned w) { return (float)__builtin_bit_cast(f16x2_t, w)[1]; }
__device__ __forceinline__ float fast_sigmoid(float x) { return __builtin_amdgcn_rcpf(1.0f + __builtin_amdgcn_exp2f(-1.4426950409f * x)); }
__device__ __forceinline__ float gelu_tanh(float x) { const float t = x * (1.0f + 0.044715f * x * x) * 2.302208198f; return x * __builtin_amdgcn_rcpf(1.0f + __builtin_amdgcn_exp2f(-t)); }
__device__ __forceinline__ void conv_taps(float& acc, float x, float xp, float w1, float w0) {
    asm("s_nop 1\n\t"
        "v_fmac_f32_dpp %0, %1, %3 row_shr:1 row_mask:0xf bank_mask:0xf bound_ctrl:1\n\t"
        "v_fmac_f32_dpp %0, %2, %3 row_shl:15 row_mask:0xf bank_mask:0xf bound_ctrl:1\n\t"
        "v_fmac_f32_dpp %0, %1, %4 row_shr:2 row_mask:0xf bank_mask:0xf bound_ctrl:1\n\t"
        "v_fmac_f32_dpp %0, %2, %4 row_shl:14 row_mask:0xf bank_mask:0xf bound_ctrl:1"
        : "+v"(acc) : "v"(x), "v"(xp), "v"(w1), "v"(w0));
}

struct EpiFoxIn {
    static constexpr bool PERM = true, AFTER_DRAIN = false;
    bf16_t *Q, *Kb, *V, *G; float* LOGF; const float *qg, *kg, *bfg;
    __device__ __forceinline__ void operator()(const f32x4 (&acc)[2][2][4][2], const Unit& u, int wr, int wc, int fr, int fq) const {
        const int row0 = u.pm * BM + wr * 64 + fr; const int pn = u.pn;
        if (pn < 8) {
            const bool isq = pn < 4; const float* gn = isq ? qg : kg; const float post = isq ? 0.18033688011112042f : 1.0f;
            bf16_t* base = (isq ? Q : Kb) + ((pn & 3) * 4 + wc) * 64 + 8 * fq;
            f32x4 gv[2][2];
#pragma unroll
            for (int bj = 0; bj < 2; ++bj)
#pragma unroll
                for (int n = 0; n < 2; ++n) gv[bj][n] = *(const f32x4*)(gn + 32 * bj + 8 * fq + 4 * n) * post;
#pragma unroll
            for (int ai = 0; ai < 2; ++ai)
#pragma unroll
                for (int m = 0; m < 4; ++m) {
                    float ss = 0.f;
#pragma unroll
                    for (int bj = 0; bj < 2; ++bj)
#pragma unroll
                        for (int n = 0; n < 2; ++n) { const f32x4 x = acc[ai][bj][m][n]; ss += (x[0] * x[0] + x[1] * x[1]) + (x[2] * x[2] + x[3] * x[3]); }
                    ss += __shfl_xor(ss, 16); ss += __shfl_xor(ss, 32);
                    const float r = __builtin_amdgcn_rsqf(ss * (1.0f / 64.0f) + 1e-6f);
                    bf16_t* rowp = base + (size_t)(row0 + ai * HALF + m * 16) * 1024;
#pragma unroll
                    for (int bj = 0; bj < 2; ++bj) { const f32x4 v0 = acc[ai][bj][m][0] * r * gv[bj][0], v1 = acc[ai][bj][m][1] * r * gv[bj][1];
                        u32x4 w; w.x = cvt_pk_bf16(v0[0], v0[1]); w.y = cvt_pk_bf16(v0[2], v0[3]); w.z = cvt_pk_bf16(v1[0], v1[1]); w.w = cvt_pk_bf16(v1[2], v1[3]);
                        *(u32x4*)(rowp + 32 * bj) = w; }
                }
        } else if (pn < 16) {
            const bool isv = pn < 12; bf16_t* base = (isv ? V : G) + ((pn & 3) * 4 + wc) * 64 + 8 * fq;
#pragma unroll
            for (int ai = 0; ai < 2; ++ai)
#pragma unroll
                for (int m = 0; m < 4; ++m) { bf16_t* rowp = base + (size_t)(row0 + ai * HALF + m * 16) * 1024;
#pragma unroll
                    for (int bj = 0; bj < 2; ++bj) { f32x4 v0 = acc[ai][bj][m][0], v1 = acc[ai][bj][m][1];
                        if (!isv) {
#pragma unroll
                            for (int j = 0; j < 4; ++j) { v0[j] = fast_sigmoid(v0[j]); v1[j] = fast_sigmoid(v1[j]); } }
                        u32x4 w; w.x = cvt_pk_bf16(v0[0], v0[1]); w.y = cvt_pk_bf16(v0[2], v0[3]); w.z = cvt_pk_bf16(v1[0], v1[1]); w.w = cvt_pk_bf16(v1[2], v1[3]);
                        *(u32x4*)(rowp + 32 * bj) = w; } }
        } else {
            if (wc == 0 && fq < 2) {
#pragma unroll
                for (int n = 0; n < 2; ++n) { const f32x4 bb = *(const f32x4*)(bfg + 8 * fq + 4 * n);
#pragma unroll
                    for (int ai = 0; ai < 2; ++ai)
#pragma unroll
                        for (int m = 0; m < 4; ++m) { const int row = row0 + ai * HALF + m * 16, b = row >> 13, s = row & 8191;
#pragma unroll
                            for (int j = 0; j < 4; ++j) { const float x = acc[ai][0][m][n][j] + bb[j]; const float lf = fminf(x, 0.f) - __logf(1.0f + __expf(-fabsf(x)));
                                LOGF[((size_t)(b * 16 + 8 * fq + 4 * n + j) << 13) + s] = lf; } } }
            }
        }
    }
};
template <bool BASE_F32> struct EpiRes {
    static constexpr bool PERM = true, AFTER_DRAIN = false;
    const void* base; unsigned short* out; const float* gate;
    __device__ __forceinline__ void operator()(const f32x4 (&acc)[2][2][4][2], const Unit& u, int wr, int wc, int fr, int fq) const {
        const float* gb = gate + (u.pm >> 5) * 6144; const int col0 = u.pn * BM + wc * 32 + 8 * fq;
        f32x4 gv[2][2];
#pragma unroll
        for (int bj = 0; bj < 2; ++bj)
#pragma unroll
            for (int n = 0; n < 2; ++n) gv[bj][n] = *(const f32x4*)(gb + col0 + bj * HALF + 4 * n);
#pragma unroll
        for (int ai = 0; ai < 2; ++ai) { const size_t off0 = (size_t)(u.pm * BM + ai * HALF + wr * 64 + fr) * 1024 + col0;
            f32x4 bs[4][2][2];
            if (BASE_F32) {
#pragma unroll
                for (int m = 0; m < 4; ++m)
#pragma unroll
                    for (int bj = 0; bj < 2; ++bj)
#pragma unroll
                        for (int n = 0; n < 2; ++n) bs[m][bj][n] = *(const f32x4*)((const float*)base + off0 + (size_t)m * 16 * 1024 + bj * HALF + 4 * n);
            } else {
                u32x4 bh[4][2];
#pragma unroll
                for (int m = 0; m < 4; ++m)
#pragma unroll
                    for (int bj = 0; bj < 2; ++bj) bh[m][bj] = *(const u32x4*)((const unsigned short*)base + off0 + (size_t)m * 16 * 1024 + bj * HALF);
#pragma unroll
                for (int m = 0; m < 4; ++m)
#pragma unroll
                    for (int bj = 0; bj < 2; ++bj) { bs[m][bj][0] = (f32x4){h_lo(bh[m][bj].x), h_hi(bh[m][bj].x), h_lo(bh[m][bj].y), h_hi(bh[m][bj].y)}; bs[m][bj][1] = (f32x4){h_lo(bh[m][bj].z), h_hi(bh[m][bj].z), h_lo(bh[m][bj].w), h_hi(bh[m][bj].w)}; }
            }
#pragma unroll
            for (int m = 0; m < 4; ++m)
#pragma unroll
                for (int bj = 0; bj < 2; ++bj) { const f32x4 o0 = bs[m][bj][0] + gv[bj][0] * acc[ai][bj][m][0], o1 = bs[m][bj][1] + gv[bj][1] * acc[ai][bj][m][1];
                    u32x4 w; w.x = pk_h2(o0[0], o0[1]); w.y = pk_h2(o0[2], o0[3]); w.z = pk_h2(o1[0], o1[1]); w.w = pk_h2(o1[2], o1[3]);
                    *(u32x4*)(out + off0 + (size_t)m * 16 * 1024 + bj * HALF) = w; }
            asm volatile("" ::: "memory"); }
    }
};
struct EpiSguIn {
    static constexpr bool PERM = true, AFTER_DRAIN = false;
    bf16_t *U, *V; const float* bias; float* stats;
    __device__ __forceinline__ void operator()(const f32x4 (&acc)[2][2][4][2], const Unit& u, int wr, int wc, int fr, int fq) const {
        const int pn = u.pn; const bool isv = pn >= 8; const int row0 = u.pm * BM + wr * 64 + fr;
        const int bcol0 = pn * BM + wc * 32 + 8 * fq; bf16_t* base = (isv ? V : U) + ((pn & 7) * BM + wc * 32 + 8 * fq);
        f32x4 bv[2][2];
#pragma unroll
        for (int bj = 0; bj < 2; ++bj)
#pragma unroll
            for (int n = 0; n < 2; ++n) bv[bj][n] = *(const f32x4*)(bias + bcol0 + bj * HALF + 4 * n);
#pragma unroll
        for (int ai = 0; ai < 2; ++ai)
#pragma unroll
            for (int m = 0; m < 4; ++m) { const int row = row0 + ai * HALF + m * 16; bf16_t* rowp = base + (size_t)row * 2048; float s1 = 0.f, s2 = 0.f;
#pragma unroll
                for (int bj = 0; bj < 2; ++bj) { f32x4 v0 = acc[ai][bj][m][0] + bv[bj][0], v1 = acc[ai][bj][m][1] + bv[bj][1];
                    if (isv) { for (int j = 0; j < 4; ++j) { v0[j] = gelu_tanh(v0[j]); v1[j] = gelu_tanh(v1[j]); } }
                    s1 += ((v0[0] + v0[1]) + (v0[2] + v0[3])) + ((v1[0] + v1[1]) + (v1[2] + v1[3]));
                    s2 += ((v0[0] * v0[0] + v0[1] * v0[1]) + (v0[2] * v0[2] + v0[3] * v0[3])) + ((v1[0] * v1[0] + v1[1] * v1[1]) + (v1[2] * v1[2] + v1[3] * v1[3]));
                    u32x4 w; w.x = cvt_pk_bf16(v0[0], v0[1]); w.y = cvt_pk_bf16(v0[2], v0[3]); w.z = cvt_pk_bf16(v1[0], v1[1]); w.w = cvt_pk_bf16(v1[2], v1[3]);
                    *(u32x4*)(rowp + bj * HALF) = w; }
                if (isv) { s1 += __shfl_xor(s1, 16); s1 += __shfl_xor(s1, 32); s2 += __shfl_xor(s2, 16); s2 += __shfl_xor(s2, 32);
                    if (fq == 0) { typedef float f32x2v __attribute__((ext_vector_type(2))); *(f32x2v*)(stats + ((size_t)row * 32 + (pn - 8) * 4 + wc) * 2) = (f32x2v){s1, s2}; } } }
    }
};
struct EpiFfnUp {
    static constexpr bool PERM = true, AFTER_DRAIN = false;
    bf16_t* ACT; const float *cw, *cb;
    __device__ __forceinline__ void operator()(const f32x4 (&acc)[2][2][4][2], const Unit& u, int wr, int wc, int fr, int fq) const {
        const int b = u.pm / 34, pmb = u.pm % 34; const int ch0 = u.pn * 128 + wc * 32 + 8 * fq;
        typedef unsigned u32x2v __attribute__((ext_vector_type(2)));
        u32x2v pk[2][4];
#pragma unroll
        for (int n = 0; n < 2; ++n) {
            const float* cwp = cw + ch0 + 4 * n; const float* cbp = cb + ch0 + 4 * n;
            const f32x4 w0g = *(const f32x4*)(cwp), w1g = *(const f32x4*)(cwp + 5632), w2g = *(const f32x4*)(cwp + 2 * 5632), bg = *(const f32x4*)(cbp);
            const f32x4 w0v = *(const f32x4*)(cwp + 2816), w1v = *(const f32x4*)(cwp + 5632 + 2816), w2v = *(const f32x4*)(cwp + 2 * 5632 + 2816), bvv = *(const f32x4*)(cbp + 2816);
#pragma unroll
            for (int ai = 0; ai < 2; ++ai) { const int j = 2 * ai + wr; const bool first = (pmb == 0) && (j == 0); const int tb = 248 * pmb + 62 * j - 2 + fr;
                f32x4 pg, pv;
#pragma unroll
                for (int m = 0; m < 4; ++m) { f32x4 g = acc[ai][0][m][n], v = acc[ai][1][m][n];
                    if (m == 0) { if (first && fr < 2) { g = (f32x4){0.f, 0.f, 0.f, 0.f}; v = g; } pg = g; pv = v; }
                    f32x4 r;
#pragma unroll
                    for (int c = 0; c < 4; ++c) {
                        float cg = w2g[c] * g[c] + bg[c]; conv_taps(cg, g[c], pg[c], w1g[c], w0g[c]);
                        float cv = w2v[c] * v[c] + bvv[c]; conv_taps(cv, v[c], pv[c], w1v[c], w0v[c]);
                        r[c] = cg * cv * fast_sigmoid(cg); }
                    pg = g; pv = v;
                    u32x2v w; w.x = cvt_pk_bf16(r[0], r[1]); w.y = cvt_pk_bf16(r[2], r[3]);
                    if (n == 0) pk[ai][m] = w;
                    else { const int t = tb + 16 * m; if ((m > 0 || fr >= 2) && t < 8192) { u32x4 o; o.x = pk[ai][m].x; o.y = pk[ai][m].y; o.z = w.x; o.w = w.y;
                            *(u32x4*)(ACT + ((size_t)b * 8192 + t) * 2816 + ch0) = o; } }
                } }
        }
    }
};

template <class Epi, class Sched, bool ALIGN_EPI = false, bool SP2 = false, bool OVL = false>
__device__ __forceinline__ void gemm_phase(PG8_LAS unsigned char* lds, const Gemm g, const Sched& S, const Epi& E) {
    const int tid = threadIdx.x, wid = __builtin_amdgcn_readfirstlane(tid >> 6), lane = tid & 63, wr = wid >> 2, wc = wid & 3, fr = lane & 15, fq = lane >> 4;
    const int K = g.K, nt = K / BK;
    unsigned voffA[2], voffB[2];
#pragma unroll
    for (int i = 0; i < 2; ++i) { int R, C; stage_rc(tid * 16 + i * 8192, R, C); const int Rb = Epi::PERM ? ((R & ~31) + perm32(R & 31)) : R;
        { const int Ra = OVL ? (R - 2 * (R >> 6)) : R; voffA[i] = (unsigned)(Ra * K + C) * 2u; } voffB[i] = (unsigned)(Rb * K + C) * 2u; }
    const size_t kstep = (size_t)(BK * 2);
    const size_t hstep = (size_t)HALF * K * 2;
    const size_t tstep = 2 * hstep;
    const size_t hstepA = OVL ? (size_t)124 * K * 2 : hstep;
#define PG8_AOFF(pm) (OVL ? ((size_t)((pm) / 34) * 8192 + (size_t)((pm) % 34) * 248) * (size_t)K * 2 : (size_t)(pm) * tstep)
    const unsigned ldsw = (unsigned)wid * 1024u;
    const int aoff = lds_byte(wr * 64 + fr, fq * 8), boff = lds_byte(wc * 32 + fr, fq * 8);
#define PG8_SA(b, h) (((b) * 2 + (h)) * HTB)
#define PG8_SB(b, h) ((4 + (b) * 2 + (h)) * HTB)
#define PG8_STAGE(bufoff, gbase, voff) do { _Pragma("unroll") for (int _i = 0; _i < 2; ++_i) \
        __builtin_amdgcn_global_load_lds((const unsigned*)((const char*)(gbase) + (voff)[_i]), (PG8_LAS unsigned*)(lds + (bufoff) + ldsw + _i * 8192), 16, 0, 0); } while (0)
#define PG8_LDA(dst, b, h) do { _Pragma("unroll") for (int m = 0; m < 4; ++m) _Pragma("unroll") for (int k = 0; k < 2; ++k) dst[m][k] = *(const PG8_LAS bf16x8*)(lds + PG8_SA(b, h) + aoff + m * 2048 + k * 1024); } while (0)
#define PG8_LDB(dst, b, h) do { _Pragma("unroll") for (int n = 0; n < 2; ++n) _Pragma("unroll") for (int k = 0; k < 2; ++k) dst[n][k] = *(const PG8_LAS bf16x8*)(lds + PG8_SB(b, h) + boff + n * 2048 + k * 1024); } while (0)
#define PG8_MMA(ai, bj, At, Bt) do { __builtin_amdgcn_s_setprio(1); _Pragma("unroll") for (int m = 0; m < 4; ++m) _Pragma("unroll") for (int n = 0; n < 2; ++n) _Pragma("unroll") for (int k = 0; k < 2; ++k) \
        acc[ai][bj][m][n] = __builtin_amdgcn_mfma_f32_16x16x32_bf16(Bt[n][k], At[m][k], acc[ai][bj][m][n], 0, 0, 0); __builtin_amdgcn_s_setprio(0); } while (0)
#define PG8_WAIT_V(n) asm volatile("s_waitcnt vmcnt(" #n ")" ::: "memory")
#define PG8_WAIT_L(n) asm volatile("s_waitcnt lgkmcnt(" #n ")" ::: "memory")
#define PG8_BAR __builtin_amdgcn_s_barrier()
#define PG8_SCHED __builtin_amdgcn_sched_barrier(0)
    Unit cur, nxt; int ui = 0;
    if (!S.next(0, cur)) return;
    f32x4 acc[2][2][4][2];
#pragma unroll
    for (int a = 0; a < 2; ++a)
#pragma unroll
        for (int b = 0; b < 2; ++b)
#pragma unroll
            for (int m = 0; m < 4; ++m)
#pragma unroll
                for (int n = 0; n < 2; ++n) acc[a][b][m][n] = (f32x4){0.f, 0.f, 0.f, 0.f};
    bf16x8 At[4][2], B0[2][2], B1[2][2];
    const char* cA = (const char*)g.A + PG8_AOFF(cur.pm); const char* cB = (const char*)g.Bt + (size_t)cur.pn * tstep;
    S.a_ready(cur);
    if constexpr (SP2) {
        PG8_STAGE(PG8_SB(0, 0), cB, voffB); PG8_STAGE(PG8_SB(0, 1), cB + hstep, voffB); PG8_STAGE(PG8_SA(0, 0), cA, voffA); PG8_STAGE(PG8_SA(0, 1), cA + hstepA, voffA);
        if (wr == 1) PG8_BAR;
        PG8_WAIT_V(2); PG8_BAR;
        PG8_STAGE(PG8_SB(1, 0), cB + kstep, voffB); PG8_STAGE(PG8_SA(1, 0), cA + kstep, voffA); PG8_STAGE(PG8_SB(1, 1), cB + hstep + kstep, voffB);
        PG8_WAIT_V(6); PG8_BAR;
    } else {
        PG8_STAGE(PG8_SB(0, 0), cB, voffB); PG8_STAGE(PG8_SA(0, 0), cA, voffA); PG8_STAGE(PG8_SB(0, 1), cB + hstep, voffB); PG8_STAGE(PG8_SA(0, 1), cA + hstepA, voffA);
        if (wr == 1) PG8_BAR;
        PG8_WAIT_V(4); PG8_BAR;
        PG8_STAGE(PG8_SB(1, 0), cB + kstep, voffB); PG8_STAGE(PG8_SA(1, 0), cA + kstep, voffA); PG8_STAGE(PG8_SB(1, 1), cB + hstep + kstep, voffB);
        PG8_WAIT_V(6); PG8_BAR;
    }
    for (;;) {
        const bool has_next = S.next(ui + 1, nxt);
        const char* nA = has_next ? (const char*)g.A + PG8_AOFF(nxt.pm) : cA; const char* nB = has_next ? (const char*)g.Bt + (size_t)nxt.pn * tstep : cB;
        for (int t = 0; t < nt; t += 2) {
            const bool last = (t == nt - 2);
            const char* a1 = cA + (size_t)(t + 1) * kstep;
            const char* a2 = last ? nA : cA + (size_t)(t + 2) * kstep; const char* b2 = last ? nB : cB + (size_t)(t + 2) * kstep;
            const char* a3 = a2 + kstep; const char* b3 = b2 + kstep;
            if (last && has_next) S.a_ready(nxt);
            if constexpr (SP2) {
            PG8_LDB(B0, 0, 0); PG8_LDB(B1, 0, 1); PG8_SCHED; PG8_LDA(At, 0, 0); PG8_STAGE(PG8_SA(1, 1), a1 + hstepA, voffA);
            PG8_WAIT_V(8); PG8_WAIT_L(0); PG8_BAR; PG8_MMA(0, 0, At, B0); PG8_MMA(0, 1, At, B1); PG8_BAR; PG8_SCHED;
            PG8_LDA(At, 0, 1); PG8_STAGE(PG8_SB(0, 0), b2, voffB); PG8_STAGE(PG8_SB(0, 1), b2 + hstep, voffB); PG8_STAGE(PG8_SA(0, 0), a2, voffA);
            PG8_WAIT_V(8); PG8_WAIT_L(0); PG8_BAR; PG8_MMA(1, 0, At, B0); PG8_MMA(1, 1, At, B1); PG8_BAR; PG8_SCHED;
            PG8_LDB(B0, 1, 0); PG8_LDB(B1, 1, 1); PG8_SCHED; PG8_LDA(At, 1, 0); PG8_STAGE(PG8_SA(0, 1), a2 + hstepA, voffA);
            PG8_WAIT_V(8); PG8_WAIT_L(0); PG8_BAR; PG8_MMA(0, 0, At, B0); PG8_MMA(0, 1, At, B1); PG8_BAR; PG8_SCHED;
            PG8_LDA(At, 1, 1); PG8_STAGE(PG8_SB(1, 0), b3, voffB); PG8_STAGE(PG8_SB(1, 1), b3 + hstep, voffB); PG8_STAGE(PG8_SA(1, 0), a3, voffA);
            PG8_WAIT_V(8); PG8_WAIT_L(0); PG8_BAR; PG8_MMA(1, 0, At, B0); PG8_MMA(1, 1, At, B1); PG8_BAR; PG8_SCHED;
            } else {
            PG8_LDB(B0, 0, 0); PG8_SCHED; PG8_LDA(At, 0, 0); PG8_STAGE(PG8_SA(1, 1), a1 + hstepA, voffA);
            PG8_WAIT_L(8); PG8_BAR; PG8_WAIT_L(0); PG8_MMA(0, 0, At, B0); PG8_BAR; PG8_SCHED;
            PG8_LDB(B1, 0, 1); PG8_STAGE(PG8_SB(0, 0), b2, voffB);
            PG8_BAR; PG8_WAIT_L(0); PG8_MMA(0, 1, At, B1); PG8_BAR;
            PG8_LDA(At, 0, 1); PG8_STAGE(PG8_SA(0, 0), a2, voffA);
            PG8_BAR; PG8_WAIT_L(0); PG8_MMA(1, 0, At, B0); PG8_BAR; PG8_SCHED;
            PG8_STAGE(PG8_SB(0, 1), b2 + hstep, voffB);
            PG8_WAIT_V(6); PG8_BAR; PG8_MMA(1, 1, At, B1); PG8_BAR;
            PG8_LDB(B0, 1, 0); PG8_SCHED; PG8_LDA(At, 1, 0); PG8_STAGE(PG8_SA(0, 1), a2 + hstepA, voffA);
            PG8_WAIT_L(8); PG8_BAR; PG8_WAIT_L(0); PG8_MMA(0, 0, At, B0); PG8_BAR; PG8_SCHED;
            PG8_LDB(B1, 1, 1); PG8_STAGE(PG8_SB(1, 0), b3, voffB);
            PG8_BAR; PG8_WAIT_L(0); PG8_MMA(0, 1, At, B1); PG8_BAR;
            PG8_LDA(At, 1, 1); PG8_STAGE(PG8_SA(1, 0), a3, voffA);
            PG8_BAR; PG8_WAIT_L(0); PG8_MMA(1, 0, At, B0); PG8_BAR; PG8_SCHED;
            PG8_STAGE(PG8_SB(1, 1), b3 + hstep, voffB);
            PG8_WAIT_V(6); PG8_BAR; PG8_MMA(1, 1, At, B1); PG8_BAR;
            }
        }
        if constexpr (ALIGN_EPI) { if (wr == 0) PG8_BAR; }
        if constexpr (!Epi::AFTER_DRAIN) { E(acc, cur, wr, wc, fr, fq); S.done(cur); }
        if (!has_next) break;
#pragma unroll
        for (int a = 0; a < 2; ++a)
#pragma unroll
            for (int b = 0; b < 2; ++b)
#pragma unroll
                for (int m = 0; m < 4; ++m)
#pragma unroll
                    for (int n = 0; n < 2; ++n) acc[a][b][m][n] = (f32x4){0.f, 0.f, 0.f, 0.f};
        cur = nxt; cA = nA; cB = nB; ++ui;
        if constexpr (ALIGN_EPI) { if (wr == 1) PG8_BAR; }
    }
    PG8_WAIT_V(0);
    if constexpr (!ALIGN_EPI) { if (wr == 0) PG8_BAR; }
    PG8_BAR;
    if constexpr (Epi::AFTER_DRAIN) { E.fused(acc, cur, wr, wc, fr, fq, lds, wid, lane); S.done(cur); }
#undef PG8_SA
#undef PG8_AOFF
#undef PG8_SB
#undef PG8_STAGE
#undef PG8_LDA
#undef PG8_LDB
#undef PG8_MMA
#undef PG8_WAIT_V
#undef PG8_WAIT_L
#undef PG8_BAR
#undef PG8_SCHED
}
}

#include <hip/hip_bf16.h>
#include <cmath>
namespace attn_body {
using bf16=__hip_bfloat16;
using bf16x8=__attribute__((ext_vector_type(8)))short;
using s16x4=__attribute__((ext_vector_type(4)))short;
using f32x16=__attribute__((ext_vector_type(16)))float;
using u32x4=__attribute__((ext_vector_type(4)))unsigned;
using f32x4v=__attribute__((ext_vector_type(4)))float;
constexpr int BATCH=4,NHEAD=16,SEQ=8192,D=64,DM=NHEAD*D;
constexpr int NW=8,QBLK=32,QB=QBLK*NW,KVBLK=64,NQB=SEQ/QB;
constexpr int ATTN_PITCH=DM, ATTN_UNIT_ROWS=QB;
__device__ __forceinline__ int crow(int r,int hi){return (r&3)+8*(r>>2)+4*hi;}
#define SBAR() __builtin_amdgcn_sched_barrier(0)
__device__ __forceinline__ void cmask(f32x16&p0,f32x16&p1,int jb,int qrel,int hi){
  const float NEG=-INFINITY; int kb=64*jb+4*hi;
  #pragma unroll
  for(int r=0;r<16;++r){int kv=kb+(r&3)+8*(r>>2); if(kv>qrel)p0[r]=NEG; if(kv+32>qrel)p1[r]=NEG;}
}

constexpr int NSLOT=3, SLOTB=8192;
constexpr int LDS_K=0, LDS_V=NSLOT*SLOTB, LDS_WS=2*NSLOT*SLOTB, LDS_OST=LDS_WS+NW*64*4, LDS_F=86016, LDS_BYTES=LDS_F+SEQ*4;
constexpr float C2=0.125f*1.4426950408889634f;
__device__ __forceinline__ void glds16(const void*gsrc,unsigned lds_dst){unsigned keep;
  asm volatile("s_mov_b32 %0, m0\n\ts_mov_b32 m0, %2\n\ts_nop 0\n\tglobal_load_lds_dwordx4 %1, off\n\ts_mov_b32 m0, %0":"=&s"(keep):"v"(gsrc),"s"(lds_dst):"memory");}
__device__ __forceinline__ float max3f(float a,float b,float c){float r;asm("v_max3_f32 %0, %1, %2, %3":"=v"(r):"v"(a),"v"(b),"v"(c));return r;}
__device__ __forceinline__ float max2f(float a,float b){float r;asm("v_max_f32_e32 %0, %1, %2":"=v"(r):"v"(a),"v"(b));return r;}
__device__ __forceinline__ float fadd_s(float a,float b){float r;asm("v_add_f32_e32 %0, %1, %2":"=v"(r):"v"(a),"v"(b));return r;}
__device__ __forceinline__ float fsub_s(float a,float b){float r;asm("v_sub_f32_e32 %0, %1, %2":"=v"(r):"v"(a),"v"(b));return r;}
typedef float f32x2_t __attribute__((ext_vector_type(2))); typedef __bf16 bf16x2_t __attribute__((ext_vector_type(2)));
__device__ __forceinline__ unsigned cvtpk_s(float lo,float hi){f32x2_t v={lo,hi};bf16x2_t b=__builtin_convertvector(v,bf16x2_t);return __builtin_bit_cast(unsigned,b);}
#define WAIT_BAR(N) asm volatile("s_waitcnt vmcnt(" #N ") lgkmcnt(0)\n\ts_barrier":::"memory")

__device__ __forceinline__ void qkt(f32x16&p0,f32x16&p1,const char*Kslot,const bf16x8*qr,int r32,int hi){
  const char*kb=Kslot+hi*1024+r32*16;
  #pragma unroll
  for(int d0=0;d0<4;++d0){
    const bf16x8 b0=*reinterpret_cast<const bf16x8*>(kb+d0*2048);
    const bf16x8 b1=*reinterpret_cast<const bf16x8*>(kb+d0*2048+512);
    {p0=__builtin_amdgcn_mfma_f32_32x32x16_bf16(b0,qr[d0],p0,0,0,0);p1=__builtin_amdgcn_mfma_f32_32x32x16_bf16(b1,qr[d0],p1,0,0,0);}}
}
typedef __attribute__((address_space(3))) const char* lds_cptr;
typedef short v4i16_t __attribute__((ext_vector_type(4)));
__device__ __forceinline__ void kload8(bf16x8*kf,lds_cptr kp){
  kf[0]=*(const __attribute__((address_space(3))) bf16x8*)(kp);      kf[1]=*(const __attribute__((address_space(3))) bf16x8*)(kp+512);
  kf[2]=*(const __attribute__((address_space(3))) bf16x8*)(kp+2048); kf[3]=*(const __attribute__((address_space(3))) bf16x8*)(kp+2560);
  kf[4]=*(const __attribute__((address_space(3))) bf16x8*)(kp+4096); kf[5]=*(const __attribute__((address_space(3))) bf16x8*)(kp+4608);
  kf[6]=*(const __attribute__((address_space(3))) bf16x8*)(kp+6144); kf[7]=*(const __attribute__((address_space(3))) bf16x8*)(kp+6656);
}
__device__ __forceinline__ void kload2(bf16x8*kf,lds_cptr kp,int j){ kf[2*j]=*(const __attribute__((address_space(3))) bf16x8*)(kp+j*2048); kf[2*j+1]=*(const __attribute__((address_space(3))) bf16x8*)(kp+j*2048+512); }
__device__ __forceinline__ s16x4 vtr(lds_cptr p){ return __builtin_bit_cast(s16x4,__builtin_amdgcn_ds_read_tr16_b64_v4i16((__attribute__((address_space(3))) v4i16_t*)p)); }
__device__ __forceinline__ float rowmax(const f32x16&p0,const f32x16&p1){
  float a=max3f(p0[0],p0[1],p1[0]),b=max3f(p0[2],p0[3],p1[1]);a=max3f(a,p1[2],p1[3]);
  #pragma unroll
  for(int r=4;r<16;r+=4){a=max3f(a,p0[r],p0[r+1]);b=max3f(b,p0[r+2],p0[r+3]);a=max3f(a,p1[r],p1[r+1]);b=max3f(b,p1[r+2],p1[r+3]);}
  const float m=max2f(a,b);
  auto rr=__builtin_amdgcn_permlane32_swap(__float_as_uint(m),__float_as_uint(m),false,false);
  return max2f(__uint_as_float(rr[0]),__uint_as_float(rr[1]));
}
__device__ __forceinline__ void pv(f32x16*o,int vb,bf16x8 pa0,bf16x8 pa1,bf16x8 pa2,bf16x8 pa3){
  #pragma unroll
  for(int d0=0;d0<2;++d0){s16x4 lo[4],hi[4];
    #pragma unroll
    for(int ks=0;ks<4;++ks){
      asm volatile("ds_read_b64_tr_b16 %0,%1 offset:%c2":"=&v"(lo[ks]):"v"(vb),"i"(d0*4096+ks*1024):"memory");
      asm volatile("ds_read_b64_tr_b16 %0,%1 offset:%c2":"=&v"(hi[ks]):"v"(vb),"i"(d0*4096+ks*1024+512):"memory");}
    asm volatile("s_waitcnt lgkmcnt(0)":::"memory");SBAR();
    #define PK(k) (bf16x8){lo[k][0],lo[k][1],lo[k][2],lo[k][3],hi[k][0],hi[k][1],hi[k][2],hi[k][3]}
    o[d0]=__builtin_amdgcn_mfma_f32_32x32x16_bf16(pa0,PK(0),o[d0],0,0,0);
    o[d0]=__builtin_amdgcn_mfma_f32_32x32x16_bf16(pa1,PK(1),o[d0],0,0,0);
    o[d0]=__builtin_amdgcn_mfma_f32_32x32x16_bf16(pa2,PK(2),o[d0],0,0,0);
    o[d0]=__builtin_amdgcn_mfma_f32_32x32x16_bf16(pa3,PK(3),o[d0],0,0,0);
    #undef PK
  }
}

#ifndef ATTN_STORE16
#define ATTN_STORE16(p,v) (*(u32x4*)(p)=(v))
#endif
template<int THRL> __device__ __forceinline__ void attn_unit(int b,int h,int qb,int t0,const bf16*Q,const bf16*__restrict__ K,const bf16*__restrict__ V,bf16*O,const bf16*__restrict__ Gt,const float*__restrict__ Fg,char*shm){
  const int tid=threadIdx.x,lane=tid&63,r32=lane&31,hi=lane>>5; const int wid=__builtin_amdgcn_readfirstlane(tid>>6);
  const long rowbase=(long)b*SEQ; const int q0=qb*QB;
  const bf16*Qw=Q+(rowbase+q0+wid*QBLK)*DM+h*D;
  const bf16*Kh=K+(rowbase+(long)t0*KVBLK)*DM+h*D,*Vh=V+(rowbase+(long)t0*KVBLK)*DM+h*D;
  const unsigned lds0=(unsigned)(uintptr_t)shm;
  float*wsf=(float*)(shm+LDS_WS)+wid*64;
  const bf16*ksrc=Kh+(long)lane*DM+wid*8;
  const bf16*vsrc=Vh+(long)(16*(wid&3)+(lane>>2))*DM+(wid>>2)*32+(lane&3)*8;
  const unsigned kdst=lds0+LDS_K+wid*1024, vdst=lds0+LDS_V+wid*1024;
  #define DMA_K(t,slot) glds16(ksrc+(long)(t)*KVBLK*DM,(unsigned)__builtin_amdgcn_readfirstlane(kdst+(slot)))
  #define DMA_V(t,slot) glds16(vsrc+(long)(t)*KVBLK*DM,(unsigned)__builtin_amdgcn_readfirstlane(vdst+(slot)))
  const int vb0=(int)(lds0+LDS_V)+((lane>>4)&1)*32+(lane&3)*8+(4*hi+((lane&15)>>2))*64;
  const char*Kbase=shm+LDS_K; bf16x8 kf[8];
  const lds_cptr shm3=(lds_cptr)shm; const lds_cptr kp0=shm3+LDS_K+hi*1024+r32*16; const lds_cptr vp0=shm3+LDS_V+((lane>>4)&1)*32+(lane&3)*8+(4*hi+((lane&15)>>2))*64;
  const int NT=(q0+QB)/KVBLK-t0;
  typedef __attribute__((address_space(3))) float* lds_fptr; typedef __attribute__((address_space(3))) const f32x4v* lds_f4c;
  const float*Fsrc=Fg+((long)b*NHEAD+h)*SEQ; const lds_fptr Fl=(lds_fptr)(shm+LDS_F);
  const float fqv=Fsrc[q0+wid*QBLK+r32]; float fqm=fqv;
  #define FLD(X0,X1,tt) do{ const lds_fptr fp_=Fl+64*(tt)+4*hi; _Pragma("unroll") for(int a_=0;a_<4;++a_){ const f32x4v u0_=*(lds_f4c)(fp_+8*a_), u1_=*(lds_f4c)(fp_+32+8*a_); \
      X0[4*a_]=u0_[0];X0[4*a_+1]=u0_[1];X0[4*a_+2]=u0_[2];X0[4*a_+3]=u0_[3]; X1[4*a_]=u1_[0];X1[4*a_+1]=u1_[1];X1[4*a_+2]=u1_[2];X1[4*a_+3]=u1_[3]; } }while(0)
  typedef float f32x2p __attribute__((ext_vector_type(2)));
  #define SUBF(X0,X1) do{ const f32x2p fq2_={fqm,fqm}; _Pragma("unroll") for(int r=0;r<16;r+=2){ f32x2p a_={X0[r],X0[r+1]}, b_={X1[r],X1[r+1]}; a_=fq2_-a_; b_=fq2_-b_; X0[r]=a_[0];X0[r+1]=a_[1];X1[r]=b_[0];X1[r+1]=b_[1]; } asm volatile("":"+v"(X0),"+v"(X1)); }while(0)
  DMA_K(0,0);DMA_V(0,0);DMA_K(1,SLOTB);
  bf16x8 qr[4];
  #pragma unroll
  for(int d0=0;d0<4;++d0)qr[d0]=*reinterpret_cast<const bf16x8*>(&Qw[(long)r32*DM+d0*16+hi*8]);
  float mhat=0.f,l_reg=0.f;f32x16 o[2];o[0]=f32x16{};o[1]=f32x16{};
  const int qrel=wid*QBLK+r32;
  #define CMASK(P0,P1,t) do{int jb_=(t)-(NT-4); if(jb_>=0)cmask(P0,P1,jb_,qrel,hi);}while(0)
  bool resc=false;
  #define START(P0,P1) do{ const float rm=rowmax(P0,P1); resc=false; \
    { const float dl=max2f(rm,0.f); mhat=fadd_s(mhat,dl); \
      _Pragma("unroll") for(int r=0;r<16;++r){P0[r]=fsub_s(P0[r],dl);P1[r]=fsub_s(P1[r],dl);} \
      fqm=fqv-mhat; } \
    _Pragma("unroll") for(int r=0;r<16;++r)P0[r]=__builtin_amdgcn_exp2f(P0[r]); }while(0)
  #define RESC() do{ if(resc){ asm volatile("s_waitcnt lgkmcnt(0)":::"memory"); \
      _Pragma("unroll") for(int d_=0;d_<2;++d_) _Pragma("unroll") for(int r=0;r<16;++r)o[d_][r]*=wsf[crow(r,hi)]; } }while(0)
  f32x16 pA0,pA1,pB0,pB1;
  int sl_prev=0,sl_cur=0,sl_next=SLOTB;
  #define ROT() do{sl_prev=sl_cur;sl_cur=sl_next;sl_next=(sl_next==(NSLOT-1)*SLOTB)?0:sl_next+SLOTB;}while(0)
  DMA_K(2,2*SLOTB);
  { const float*Fs0=Fsrc+t0*KVBLK; const int n4=NT*(KVBLK/4); for(int i=tid;i<n4;i+=NW*64){ const f32x4v v=*(const f32x4v*)(Fs0+4*i); *(__attribute__((address_space(3))) f32x4v*)(Fl+4*i)=v; } }
  WAIT_BAR(3);
  FLD(pA0,pA1,0); SUBF(pA0,pA1); qkt(pA0,pA1,Kbase,qr,r32,hi);asm volatile("s_nop 15\n\ts_nop 7":"+v"(pA0),"+v"(pA1));CMASK(pA0,pA1,0);
  START(pA0,pA1);
  _Pragma("unroll") for(int r=0;r<16;++r)pA1[r]=__builtin_amdgcn_exp2f(pA1[r]);
  WAIT_BAR(0);
  DMA_K(3,0);DMA_V(1,SLOTB);
  ROT();
  kload8(kf,kp0+sl_cur);
  FLD(pB0,pB1,1);
  WAIT_BAR(2);
  s16x4 vlo[8],vhi[8]; u32x4 pw0,pw1,pw2,pw3;
  #define PKW(P,B) cvtpk_s(P[B],P[B+1])
  #define PAF(k) __builtin_bit_cast(bf16x8,pw##k)
  #define VFR(i) (bf16x8){vlo[i][0],vlo[i][1],vlo[i][2],vlo[i][3],vhi[i][0],vhi[i][1],vhi[i][2],vhi[i][3]}
  #define PIN(x) asm volatile("":"+v"(x))
  #define MX3(a,b,c) __builtin_fmaxf(__builtin_fmaxf((a),(b)),(c))
  #define GAPA(CD,MF,A0,A1,A2,A3,W0,W1,PW) do{ MF; PIN(CD); sacc+=A0; sacc+=A1; sacc+=A2; sacc+=A3; PIN(sacc); W0; W1; PIN(PW); SBAR(); }while(0)
  #define EX(v) __builtin_amdgcn_exp2f(v)
  #define GAPB(MF,X,B) do{ MF; X[B]=EX(X[B]); X[B+1]=EX(X[B+1]); X[B+2]=EX(X[B+2]); X[B+3]=EX(X[B+3]); PIN(X); SBAR(); }while(0)
  #define VRD(i) do{ vlo[i]=vtr(vp_+(((i)>>2)*4096+((i)&3)*1024)); vhi[i]=vtr(vp_+(((i)>>2)*4096+((i)&3)*1024+512)); }while(0)
  #define KRD(G,j) do{ if(G){ kload2(kf,kp0+sl_next,j); SBAR(); } }while(0)
  #define STEP(C0,C1,P0,P1,t,GK,GV,GL) do{ SBAR(); SUBF(C0,C1); SBAR(); \
    const lds_cptr vp_=vp0+sl_prev; \
    VRD(0); SBAR(); float sacc=(P0[0]+P0[1]); \
    GAPA(C0,C0=__builtin_amdgcn_mfma_f32_32x32x16_bf16(kf[0],qr[0],C0,0,0,0), P0[2],P0[3],P0[4],P0[5],     pw0[0]=PKW(P0,0), pw0[1]=PKW(P0,2), pw0); \
    VRD(4); SBAR(); GAPA(C1,C1=__builtin_amdgcn_mfma_f32_32x32x16_bf16(kf[1],qr[0],C1,0,0,0), P0[6],P0[7],P0[8],P0[9],     pw0[2]=PKW(P0,4), pw0[3]=PKW(P0,6), pw0); \
    VRD(1); SBAR(); GAPA(C0,C0=__builtin_amdgcn_mfma_f32_32x32x16_bf16(kf[2],qr[1],C0,0,0,0),   P0[10],P0[11],P0[12],P0[13], pw1[0]=PKW(P0,8), pw1[1]=PKW(P0,10), pw1); \
    VRD(5); SBAR(); GAPA(C1,C1=__builtin_amdgcn_mfma_f32_32x32x16_bf16(kf[3],qr[1],C1,0,0,0),   P0[14],P0[15],P1[0],P1[1],   pw1[2]=PKW(P0,12),pw1[3]=PKW(P0,14), pw1); \
    VRD(2); SBAR(); GAPA(C0,C0=__builtin_amdgcn_mfma_f32_32x32x16_bf16(kf[4],qr[2],C0,0,0,0),   P1[2],P1[3],P1[4],P1[5],     pw2[0]=PKW(P1,0), pw2[1]=PKW(P1,2), pw2); \
    VRD(6); SBAR(); GAPA(C1,C1=__builtin_amdgcn_mfma_f32_32x32x16_bf16(kf[5],qr[2],C1,0,0,0),   P1[6],P1[7],P1[8],P1[9],     pw2[2]=PKW(P1,4), pw2[3]=PKW(P1,6), pw2); \
    VRD(3); SBAR(); GAPA(C0,C0=__builtin_amdgcn_mfma_f32_32x32x16_bf16(kf[6],qr[3],C0,0,0,0),   P1[10],P1[11],P1[12],P1[13], pw3[0]=PKW(P1,8), pw3[1]=PKW(P1,10), pw3); \
    VRD(7); SBAR(); GAPA(C1,C1=__builtin_amdgcn_mfma_f32_32x32x16_bf16(kf[7],qr[3],C1,0,0,0),   P1[14],P1[15],0.f,0.f,       pw3[2]=PKW(P1,12),pw3[3]=PKW(P1,14), pw3); \
    l_reg+=sacc; if(GL){ FLD(P0,P1,(t)+1); } \
    if(GK){DMA_K((t)+3,sl_cur);} if(GV){DMA_V((t)+1,sl_next);} \
    CMASK(C0,C1,t); \
    { float a=MX3(C0[0],C0[1],C1[0]),b=MX3(C0[2],C0[3],C1[1]); a=MX3(a,C1[2],C1[3]); \
      _Pragma("unroll") for(int r=4;r<16;r+=4){a=MX3(a,C0[r],C0[r+1]);b=MX3(b,C0[r+2],C0[r+3]);a=MX3(a,C1[r],C1[r+1]);b=MX3(b,C1[r+2],C1[r+3]);} \
      float rm=__builtin_fmaxf(a,b); { auto rr=__builtin_amdgcn_permlane32_swap(__float_as_uint(rm),__float_as_uint(rm),false,false); rm=__builtin_fmaxf(__uint_as_float(rr[0]),__uint_as_float(rr[1])); } \
      resc=false; \
      if(__builtin_expect(__any(rm>(float)THRL),0)){ const float dl=__builtin_fmaxf(rm,0.f); mhat+=dl; \
        _Pragma("unroll") for(int r=0;r<16;++r){C0[r]-=dl;C1[r]-=dl;} \
        fqm=fqv-mhat; \
        const float f=__builtin_amdgcn_exp2f(-dl); l_reg*=f; if(hi==0)wsf[r32]=f; resc=true; } } \
    SBAR(); \
    GAPB(o[0]=__builtin_amdgcn_mfma_f32_32x32x16_bf16(PAF(0),VFR(0),o[0],0,0,0), C0,0); \
    GAPB(o[1]=__builtin_amdgcn_mfma_f32_32x32x16_bf16(PAF(0),VFR(4),o[1],0,0,0), C0,4); \
    KRD(GL,0); GAPB(o[0]=__builtin_amdgcn_mfma_f32_32x32x16_bf16(PAF(1),VFR(1),o[0],0,0,0), C0,8); \
    KRD(GL,1); GAPB(o[1]=__builtin_amdgcn_mfma_f32_32x32x16_bf16(PAF(1),VFR(5),o[1],0,0,0), C0,12); \
    KRD(GL,2); GAPB(o[0]=__builtin_amdgcn_mfma_f32_32x32x16_bf16(PAF(2),VFR(2),o[0],0,0,0), C1,0); \
    KRD(GL,3); GAPB(o[1]=__builtin_amdgcn_mfma_f32_32x32x16_bf16(PAF(2),VFR(6),o[1],0,0,0), C1,4); \
    GAPB(o[0]=__builtin_amdgcn_mfma_f32_32x32x16_bf16(PAF(3),VFR(3),o[0],0,0,0), C1,8); \
    GAPB(o[1]=__builtin_amdgcn_mfma_f32_32x32x16_bf16(PAF(3),VFR(7),o[1],0,0,0), C1,12); \
    }while(0)
  int t=1;
  #undef CMASK
  #define CMASK(P0,P1,t) do{}while(0)
  for(;t+5<NT;t+=2){
    STEP(pB0,pB1,pA0,pA1,t,true,true,true);     WAIT_BAR(2); RESC(); ROT();
    STEP(pA0,pA1,pB0,pB1,t+1,true,true,true);   WAIT_BAR(2); RESC(); ROT();
  }
  #undef CMASK
  #define CMASK(P0,P1,t) do{int jb_=(t)-(NT-4); if(jb_>=0)cmask(P0,P1,jb_,qrel,hi);}while(0)
  #define ENDW(tt) do{ if((tt)+3<NT){WAIT_BAR(2);} else if((tt)+2<NT){WAIT_BAR(1);} else {WAIT_BAR(0);} }while(0)
  for(;t+1<NT;t+=2){
    STEP(pB0,pB1,pA0,pA1,t,(t+3<NT),(t+1<NT),(t+1<NT));       ENDW(t);   RESC(); ROT();
    STEP(pA0,pA1,pB0,pB1,t+1,(t+4<NT),(t+2<NT),(t+2<NT));     ENDW(t+1); RESC(); ROT();
  }
  STEP(pB0,pB1,pA0,pA1,NT-1,false,false,false); RESC();
  { float sacc=pB0[0]+pB0[1]; _Pragma("unroll") for(int r=2;r<16;++r)sacc+=pB0[r]; _Pragma("unroll") for(int r=0;r<16;++r)sacc+=pB1[r]; l_reg+=sacc;
    pw0=(u32x4){PKW(pB0,0),PKW(pB0,2),PKW(pB0,4),PKW(pB0,6)};pw1=(u32x4){PKW(pB0,8),PKW(pB0,10),PKW(pB0,12),PKW(pB0,14)};pw2=(u32x4){PKW(pB1,0),PKW(pB1,2),PKW(pB1,4),PKW(pB1,6)};pw3=(u32x4){PKW(pB1,8),PKW(pB1,10),PKW(pB1,12),PKW(pB1,14)};
    SBAR(); pv(o,vb0+sl_cur,PAF(0),PAF(1),PAF(2),PAF(3)); }
  #undef PKW
  #undef PAF
  #undef VFR
  #undef PIN
  #undef MX3
  #undef GAPA
  #undef GAPB
  #undef EX
  #undef VRD
  #undef KRD
  #undef STEP
  #undef ENDW
  {auto rr=__builtin_amdgcn_permlane32_swap(__float_as_uint(l_reg),__float_as_uint(l_reg),false,false);l_reg=__uint_as_float(rr[0])+__uint_as_float(rr[1]);}
  if(hi==0)wsf[32+r32]=l_reg;asm volatile("s_waitcnt lgkmcnt(0)":::"memory");
  float rli[16];
  #pragma unroll
  for(int r=0;r<16;++r)rli[r]=__builtin_amdgcn_rcpf(wsf[32+crow(r,hi)]);
  bf16*Ow=O+(rowbase+q0+wid*QBLK)*DM+h*D; const bf16*Gw=Gt+(rowbase+q0+wid*QBLK)*DM+h*D;
  { bf16*stg=(bf16*)(shm+LDS_OST)+wid*2048;
    #pragma unroll
    for(int r=0;r<16;++r){const int orow=crow(r,hi);
      #pragma unroll
      for(int d0=0;d0<2;++d0)stg[orow*64+d0*32+r32]=__float2bfloat16(o[d0][r]*rli[r]);}
    asm volatile("s_waitcnt lgkmcnt(0)":::"memory");
    #pragma unroll
    for(int i=0;i<4;++i){const int row=i*8+(lane>>3),ch=lane&7; u32x4 v=*(const u32x4*)(stg+row*64+ch*8); const u32x4 gv=*(const u32x4*)(Gw+(long)row*DM+ch*8);
      _Pragma("unroll") for(int e=0;e<4;++e){ const float a0=__uint_as_float(v[e]<<16),a1=__uint_as_float(v[e]&0xffff0000u),g0=__uint_as_float(gv[e]<<16),g1=__uint_as_float(gv[e]&0xffff0000u); v[e]=cvtpk_s(a0*g0,a1*g1); }
      ATTN_STORE16(Ow+(long)row*DM+ch*8,v);} }
  asm volatile("s_waitcnt lgkmcnt(0)\n\ts_barrier":::"memory");
  #undef DMA_K
  #undef FLD
  #undef SUBF
  #undef DMA_V
  #undef CMASK
  #undef START
  #undef RESC
  #undef ROT
}
constexpr int ATTN_LDS_BYTES=LDS_BYTES;
constexpr long K_OFF=-67108864L, V_OFF=-33554432L, G_OFF=33554432L, O_OFF=-101711872L;
struct AttnTensors { bf16* Q; const float* F; const int* T0; };
struct AttnUnit { int bh; int qb; int t0; };
struct StaticOrder {
  const int* lst; int n;
  __device__ __forceinline__ explicit StaticOrder(const int* l,int cnt):lst(l),n(cnt){}
  __device__ __forceinline__ bool next(int i,AttnUnit&u)const{ if(i>=n)return false; const int w=__builtin_amdgcn_readfirstlane(lst[i]); const int un=w&0xffff; u.bh=un>>5; u.qb=un&31; u.t0=w>>16; return true; }
  __device__ __forceinline__ void a_ready(const AttnUnit&)const{}
  __device__ __forceinline__ void done(const AttnUnit&)const{}
};
template<class Sched,int THRL=8> __device__ __forceinline__ void attn_phase(char*lds,const AttnTensors&T,const Sched&S){
  AttnUnit u;
  for(int i=0;S.next(i,u);++i){ S.a_ready(u); attn_unit<THRL>(u.bh/NHEAD,u.bh%NHEAD,u.qb,u.t0,T.Q,T.Q+K_OFF,T.Q+V_OFF,T.Q+O_OFF,T.Q+G_OFF,T.F,lds); S.done(u); }
}
#undef SBAR
#undef WAIT_BAR
}

namespace cg = cooperative_groups;
constexpr int NWAVES = 8;
constexpr int BATCH = 4, SEQ = 8192, D = 1024, M = BATCH * SEQ, DFF = 2816, SGW = 2048;
constexpr float EPS = 1e-6f;
constexpr int NSYNC = 1;
constexpr unsigned long long REPMASK = 0ull;
constexpr size_t MiB = 1u << 20;
constexpr size_t WS_MODP = 1 * MiB, WS_MOD = 4 * MiB, WS_T0 = 4 * MiB + 512 * 1024, WS_WSM = 5 * MiB;
constexpr size_t WS_WFI = 6 * MiB, WS_WFO = 15 * MiB, WS_WSI = 17 * MiB, WS_WSO = 25 * MiB, WS_WUP0 = 29 * MiB, WS_WUP1 = 40 * MiB, WS_WDN0 = 51 * MiB, WS_WDN1 = 57 * MiB;
constexpr size_t WS_HN = 66 * MiB, WS_X1 = 132 * MiB, WS_K = 132 * MiB, WS_V = 196 * MiB, WS_VS = 132 * MiB;
constexpr size_t WS_Q = 260 * MiB, WS_G = 324 * MiB, WS_ACT = 260 * MiB, WS_U = 260 * MiB;
constexpr size_t WS_LOGF = 436 * MiB, WS_F = 438 * MiB, WS_STATS = 440 * MiB, WS_END = 448 * MiB;
constexpr int RING_BYTES = 131072, LDS_BYTES = 147456, LDSCTL_OFF = 143360;
constexpr size_t WS_CTL = 0, CTL_ZERO_BYTES = 65536;
static_assert(attn_body::ATTN_LDS_BYTES <= RING_BYTES, "attention LDS");

#define GAS __attribute__((address_space(1)))
#define LAS __attribute__((address_space(3)))
typedef unsigned short bf16;
typedef unsigned v4u __attribute__((ext_vector_type(4)));
typedef unsigned v2u __attribute__((ext_vector_type(2)));
typedef float f32x4 __attribute__((ext_vector_type(4)));
typedef float f32x2 __attribute__((ext_vector_type(2)));
typedef short bf16x8 __attribute__((ext_vector_type(8)));
#define LDS_WAIT() asm volatile("s_waitcnt lgkmcnt(0)" ::: "memory")
__device__ __forceinline__ unsigned f2bf(float f) { unsigned u = __builtin_bit_cast(unsigned, f); return (u + 0x7fffu + ((u >> 16) & 1u)) >> 16; }
__device__ __forceinline__ unsigned pk2(float lo, float hi) { return f2bf(lo) | (f2bf(hi) << 16); }
__device__ __forceinline__ float bflo(unsigned w) { return __uint_as_float(w << 16); }
__device__ __forceinline__ float bfhi(unsigned w) { return __uint_as_float(w & 0xffff0000u); }
__device__ __forceinline__ float wave_sum(float v) {
#pragma unroll
    for (int o = 1; o < 64; o <<= 1) v += __shfl_xor(v, o);
    return v;
}
template <int MODE> __device__ __forceinline__ int phys_blk(int nb) {
    if (MODE == 1) { if (nb >= 128) return nb; const int pn = nb >> 3, r = nb & 7; return pn * 8 + (r & 1) * 4 + (r >> 1); }
    if (MODE == 2) { const int bj = nb / 88, q = nb % 88; return (q >> 2) * 8 + bj * 4 + (q & 3); }
    return nb;
}
template <int MODE> __device__ __forceinline__ void transpose_item(const float* W, int K, int N, bf16* WT, LAS float* scr, int item, int lane) {
    const int nblk = (N + 63) / 64, kb = item / nblk, nb = item % nblk, k0 = 64 * kb, n0 = 64 * nb; const int kr = lane >> 4, nc = 4 * (lane & 15); const bool ok = n0 + nc < N;
#pragma unroll 8
    for (int i = 0; i < 16; ++i) { const int kk = 4 * i + kr; f32x4 v = (f32x4){0.f, 0.f, 0.f, 0.f}; if (ok) v = *(const f32x4*)(W + (size_t)(k0 + kk) * N + n0 + nc);
        LAS float* d = scr + kk * 65 + nc; d[0] = v.x; d[1] = v.y; d[2] = v.z; d[3] = v.w; }
    LDS_WAIT(); asm volatile("" ::: "memory");
    const int c = lane & 7;
#pragma unroll
    for (int j = 0; j < 8; ++j) { const int n = (lane >> 3) + 8 * j; const int pb = phys_blk<MODE>(2 * nb + (n >> 5)); const LAS float* s = scr + (8 * c) * 65 + n;
        v4u o; o.x = pk2(s[0 * 65], s[1 * 65]); o.y = pk2(s[2 * 65], s[3 * 65]); o.z = pk2(s[4 * 65], s[5 * 65]); o.w = pk2(s[6 * 65], s[7 * 65]);
        *(GAS v4u*)(WT + (size_t)(pb * 32 + (n & 31)) * K + k0 + 8 * c) = o; }
    LDS_WAIT(); asm volatile("" ::: "memory");
}
__device__ __forceinline__ void norm_row_bf16(const unsigned short* xrow, const float* g, const float* sh, const float* sc, bf16* orow, int lane) {
    const v4u a = *(const GAS v4u*)(xrow + 8 * lane), b = *(const GAS v4u*)(xrow + 512 + 8 * lane); float v[16]; float s = 0.f;
#pragma unroll
    for (int i = 0; i < 4; ++i) { v[2 * i] = pg8::h_lo(a[i]); v[2 * i + 1] = pg8::h_hi(a[i]); v[8 + 2 * i] = pg8::h_lo(b[i]); v[8 + 2 * i + 1] = pg8::h_hi(b[i]); }
#pragma unroll
    for (int i = 0; i < 16; ++i) s += v[i] * v[i];
    const float rstd = 1.0f / sqrtf(wave_sum(s) * (1.f / D) + EPS);
#pragma unroll
    for (int h = 0; h < 2; ++h) { const int c = 512 * h + 8 * lane; v4u w;
#pragma unroll
        for (int q = 0; q < 2; ++q) { const f32x4 gg = *(const f32x4*)(g + c + 4 * q), s1 = *(const f32x4*)(sc + c + 4 * q), s0 = *(const f32x4*)(sh + c + 4 * q);
            const f32x4 x4 = {v[8 * h + 4 * q], v[8 * h + 4 * q + 1], v[8 * h + 4 * q + 2], v[8 * h + 4 * q + 3]}; const f32x4 y = x4 * rstd * gg * (s1 + 1.0f) + s0;
            w[2 * q] = pk2(y.x, y.y); w[2 * q + 1] = pk2(y.z, y.w); }
        *(GAS v4u*)(orow + c) = w; }
}
#define XB_TMO      128
#define XB_XCNT(j)  (256  + 64 * (j))
#define XB_XSUB(j)  (1280 + 64 * (j))
#define XB_XGEN(j)  (2304 + 64 * (j))
#define XB_TOP      3328
#define XB_TOPGEN   3392
#define XCD_BAR_WORDS 3456
#define XB_SPIN_CAP (1u << 18)

__device__ __forceinline__ unsigned xb_ld(unsigned* p)              { return __hip_atomic_load(p, __ATOMIC_RELAXED, __HIP_MEMORY_SCOPE_AGENT); }
__device__ __forceinline__ unsigned xb_add(unsigned* p, unsigned v) { return __hip_atomic_fetch_add(p, v, __ATOMIC_RELAXED, __HIP_MEMORY_SCOPE_AGENT); }
__device__ __forceinline__ unsigned xb_xcc_id() { return (unsigned)__builtin_amdgcn_s_getreg((3 << 11) | 20) & 0xFu; }
#define XB_SPIN(cond, bar) do { unsigned _sp = 0; while (cond) { __builtin_amdgcn_s_sleep(1); \
    if ((++_sp & 255u) == 0u) { if (xb_ld(&(bar)[XB_TMO])) break; if (_sp > XB_SPIN_CAP) { atomicAdd(&(bar)[XB_TMO], 1u); break; } } } } while (0)

struct XcdBarrier {
    unsigned* bar; unsigned x;
    volatile LAS unsigned* st;
};

__device__ __forceinline__ XcdBarrier xcd_barrier_post(unsigned* bar, volatile LAS unsigned* st) {
    XcdBarrier b; b.bar = bar; b.x = xb_xcc_id(); b.st = st;
    if (threadIdx.x == 0) (void)xb_add(&bar[XB_XCNT(b.x)], 1u);
    return b;
}
__device__ __forceinline__ void xcd_barrier_complete(unsigned* bar, unsigned x, unsigned& nloc, unsigned& nx) {
    const unsigned G = gridDim.x * gridDim.y * gridDim.z;
    unsigned sum, cnt, mine, sp = 0u;
    for (;;) {
        sum = 0u; cnt = 0u; mine = 0u;
#pragma unroll
        for (unsigned j = 0; j < 16; ++j) { const unsigned c = xb_ld(&bar[XB_XCNT(j)]); sum += c; cnt += (c > 0u) ? 1u : 0u; mine = (j == x) ? c : mine; }
        if (sum == G) break;
        __builtin_amdgcn_s_sleep(1);
        if ((++sp & 255u) == 0u) { if (xb_ld(&bar[XB_TMO])) break; if (sp > XB_SPIN_CAP) { atomicAdd(&bar[XB_TMO], 1u); break; } }
    }
    nloc = mine > 0u ? mine : 1u; nx = cnt > 0u ? cnt : 1u;
}

__device__ __forceinline__ void xcd_barrier(const XcdBarrier& b) {
    asm volatile("s_waitcnt vmcnt(0)" ::: "memory");
    __syncthreads();
    if (threadIdx.x == 0) {
        unsigned* bar = b.bar;
        __builtin_amdgcn_s_waitcnt(0);
        unsigned nloc = b.st[0], nx = b.st[1];
        if (nloc == 0u) { xcd_barrier_complete(bar, b.x, nloc, nx); b.st[0] = nloc; b.st[1] = nx; }
        const unsigned old = xb_add(&bar[XB_XSUB(b.x)], 1u);
        const unsigned gen = old / nloc;
        if (old + 1u == (gen + 1u) * nloc) {
            __builtin_amdgcn_fence(__ATOMIC_RELEASE, "agent");
            asm volatile("s_waitcnt vmcnt(0)" ::: "memory");
            const unsigned og = xb_add(&bar[XB_TOP], 1u);
            const unsigned tg = og / nx;
            if (og + 1u == (tg + 1u) * nx) xb_add(&bar[XB_TOPGEN], 1u);
            else XB_SPIN(xb_ld(&bar[XB_TOPGEN]) == tg, bar);
            __builtin_amdgcn_fence(__ATOMIC_ACQUIRE, "agent");
            xb_add(&bar[XB_XGEN(b.x)], 1u);
            asm volatile("s_waitcnt vmcnt(0)" ::: "memory");
        } else {
            XB_SPIN(xb_ld(&bar[XB_XGEN(b.x)]) == gen, bar);
            __builtin_amdgcn_fence(__ATOMIC_ACQUIRE, "agent");
            asm volatile("s_waitcnt vmcnt(0)" ::: "memory");
        }
    }
    __syncthreads();
}

struct Args { const float* in[23]; float* out; unsigned char* ws; int ph_lo, ph_hi; };
typedef __attribute__((address_space(4))) const unsigned char* kptr_t;
__device__ __forceinline__ kptr_t kargs() { kptr_t p = (kptr_t)__builtin_amdgcn_kernarg_segment_ptr(); asm volatile("" : "+s"(p)); return p; }
#define ARGP(off, T) (*(T const __attribute__((address_space(4)))*)(kargs() + (off)))

__global__ void __launch_bounds__(NWAVES * 64, 2) fwd_mega(Args args) {
    extern __shared__ __attribute__((aligned(16))) unsigned char lds[];
    cg::grid_group grid = cg::this_grid();
    LAS unsigned char* const ldsl = (LAS unsigned char*)lds;
    const int tid = threadIdx.x, lane = tid & 63, wave = __builtin_amdgcn_readfirstlane(tid >> 6);
    const int G = gridDim.x; const int bx = blockIdx.x; const int vcu = (G % 8 == 0) ? (bx % 8) * (G / 8) + bx / 8 : bx;
    const int gw = vcu * NWAVES + wave, NGW = G * NWAVES;
#define A_IN(i) ARGP(8 * (i), const float*)
#define ws ARGP(192, unsigned char*)
#define x_in A_IN(0)
#define out ARGP(184, float*)
#define MODP ((float*)(ws + WS_MODP))
#define MOD ((float*)(ws + WS_MOD))
#define T0 ((int*)(ws + WS_T0))
#define WSM ((bf16*)(ws + WS_WSM))
#define WFI ((bf16*)(ws + WS_WFI))
#define WFO ((bf16*)(ws + WS_WFO))
#define WSI ((bf16*)(ws + WS_WSI))
#define WSO ((bf16*)(ws + WS_WSO))
#define HN ((bf16*)(ws + WS_HN))
#define X1H ((unsigned short*)(ws + WS_X1))
#define X2H2 ((unsigned short*)(ws + WS_X1 + 64 * MiB))
#define X2H ((unsigned short*)out)
#define QB ((bf16*)(ws + WS_Q))
#define KB ((bf16*)(ws + WS_K))
#define VB ((bf16*)(ws + WS_V))
#define GB ((bf16*)(ws + WS_G))
#define ACT ((bf16*)(ws + WS_ACT))
#define UB ((bf16*)(ws + WS_U))
#define VS ((bf16*)(ws + WS_VS))
#define LOGF ((float*)(ws + WS_LOGF))
#define FB ((float*)(ws + WS_F))
#define STATS ((float*)(ws + WS_STATS))
    const int lo = ARGP(200, int), hi = ARGP(204, int);
    for (int u = tid; u < 64; u += NWAVES * 64) ((LAS unsigned*)(ldsl + LDSCTL_OFF))[u] = 0u;
    __syncthreads();
    XcdBarrier bar = xcd_barrier_post((unsigned*)(ws + WS_CTL), (volatile LAS unsigned*)(ldsl + LDSCTL_OFF) + 8);
    if (lo > 4096) grid.sync();
#define PHASE_BEGIN(k) if ((k) >= lo && (k) < hi) for (int rep_ = 0; rep_ <= (int)((REPMASK >> (k)) & 1ull); ++rep_) {
#define PHASE_END(k) if ((k) + 1 < hi) { for (int s_ = 0; s_ < NSYNC; ++s_) xcd_barrier(bar); } }
#define MODV(l, k) (MOD + (size_t)(l) * 4 * 6144 + (k) * 1024)

    constexpr int CV_FI = 16 * 65, CV_FO = 16 * 16, CV_SI = 16 * 64, CV_SO = 32 * 16, CV_UP = 16 * 88, CV_DN = 44 * 16;
    constexpr int CV_G2 = CV_FI, CV_G3 = CV_G2 + CV_FO + CV_UP + CV_DN, CV_END = CV_G3 + CV_SI + CV_SO + CV_UP + CV_DN;
#define CONVERT_ITEM(R, SCR) do { int r_ = (R); \
        if (r_ < CV_FI) { transpose_item<1>(A_IN(2), D, 4112, WFI, SCR, r_, lane); break; } r_ -= CV_FI; \
        if (r_ < CV_FO) { transpose_item<0>(A_IN(6), D, D, WFO, SCR, r_, lane); break; } r_ -= CV_FO; \
        if (r_ < CV_UP) { transpose_item<2>(A_IN(14), D, 5632, (bf16*)(ws + WS_WUP0), SCR, r_, lane); break; } r_ -= CV_UP; \
        if (r_ < CV_DN) { transpose_item<0>(A_IN(17), DFF, D, (bf16*)(ws + WS_WDN0), SCR, r_, lane); break; } r_ -= CV_DN; \
        if (r_ < CV_SI) { transpose_item<0>(A_IN(7), D, 4096, WSI, SCR, r_, lane); break; } r_ -= CV_SI; \
        if (r_ < CV_SO) { transpose_item<0>(A_IN(13), SGW, D, WSO, SCR, r_, lane); break; } r_ -= CV_SO; \
        if (r_ < CV_UP) { transpose_item<2>(A_IN(14) + (size_t)D * 5632, D, 5632, (bf16*)(ws + WS_WUP1), SCR, r_, lane); break; } r_ -= CV_UP; \
        transpose_item<0>(A_IN(17) + (size_t)DFF * D, DFF, D, (bf16*)(ws + WS_WDN1), SCR, r_, lane); } while (0)
    PHASE_BEGIN(0)
    {
        LAS float* scr = (LAS float*)(ldsl + wave * 16640);
        constexpr int I_MOD = 768;
        for (int it = gw; it < I_MOD + CV_FI; it += NGW) {
            int r = it;
            if (r >= I_MOD) { CONVERT_ITEM(r - I_MOD, scr); continue; }
            if (r < I_MOD) {
                const int l = r / 384, q = r % 384, nc = q >> 4, ks = q & 15, n0 = nc * 256 + 4 * lane, k0 = ks * 64;
                float ca[4];
#pragma unroll
                for (int b = 0; b < 4; ++b) { const float cv = A_IN(1)[b * D + k0 + lane]; ca[b] = cv / (1.0f + __expf(-cv)); }
                f32x4 a[4] = {(f32x4){0, 0, 0, 0}, (f32x4){0, 0, 0, 0}, (f32x4){0, 0, 0, 0}, (f32x4){0, 0, 0, 0}};
                const float* wp = A_IN(18) + ((size_t)l * D + k0) * 6144 + n0;
#pragma unroll 16
                for (int kk = 0; kk < 64; ++kk) { const f32x4 wv = *(const f32x4*)(wp + (size_t)kk * 6144);
#pragma unroll
                    for (int b = 0; b < 4; ++b) { const float cb = __builtin_bit_cast(float, __builtin_amdgcn_readlane(__builtin_bit_cast(int, ca[b]), kk)); a[b] += wv * cb; } }
#pragma unroll
                for (int b = 0; b < 4; ++b) *(f32x4*)(MODP + ((size_t)(ks * 2 + l) * 4 + b) * 6144 + n0) = a[b];
                continue;
            }
        }
        { v4u z = {0u, 0u, 0u, 0u}; GAS v4u* p = (GAS v4u*)(WFI + (size_t)4128 * D); const int n16 = 224 * D * 2 / 16; for (int i = gw * 64 + lane; i < n16; i += NGW * 64) p[i] = z; }
        for (int i = gw * 64 + lane; i < 8 * 128 * 128 / 2; i += NGW * 64) { const int e = 2 * i, s = e & 127, t = (e >> 7) & 127; const f32x2 w = *(const f32x2*)(A_IN(11) + e);
            const bool keep = (s >> 6) <= (t >> 6); ((GAS unsigned*)WSM)[i] = keep ? pk2(w.x, w.y) : 0u; }
    }
    PHASE_END(0)
    PHASE_BEGIN(2)
    {
        for (int i = bx * 512 + tid; i < 2 * 4 * 6144; i += G * 512) { const int l = i / (4 * 6144), n = i % 6144; float s = A_IN(19)[l * 6144 + n];
#pragma unroll
            for (int ks = 0; ks < 16; ++ks) s += MODP[(size_t)ks * 2 * 4 * 6144 + i];
            MOD[i] = s; }
        LAS float* mv = (LAS float*)ldsl;
        for (int i = tid; i < 4 * 512; i += 512) { const int b = i >> 9, c4 = (i & 511) * 4; f32x4 s = *(const f32x4*)(A_IN(19) + c4);
#pragma unroll
            for (int ks = 0; ks < 16; ++ks) s += *(const f32x4*)(MODP + ((size_t)(ks * 2) * 4 + b) * 6144 + c4);
            *(LAS f32x4*)(mv + b * 2048 + c4) = s; }
        constexpr int RSW = 2064;
        LAS unsigned char* wfb = ldsl + 32768;
        for (int i = tid; i < 2048; i += 512) { const int h = i >> 7, c = i & 127; *(LAS v4u*)(wfb + h * RSW + c * 16) = *(const v4u*)(WFI + (size_t)(4096 + h) * D + c * 8); }
        __syncthreads();
        const int fr = lane & 15, fq = lane >> 4;
        for (int m0 = gw; m0 < M; m0 += 16 * NGW) {
            for (int i = 0; i < 16; ++i) { int m = m0 + i * NGW; m = m < M ? m : M - 1; const int b = m >> 13;
                const GAS f32x4* xr = (const GAS f32x4*)(x_in + (size_t)m * D) + lane; f32x4 v[4]; float s = 0.f;
#pragma unroll
                for (int j = 0; j < 4; ++j) { v[j] = __builtin_nontemporal_load(xr + 64 * j); s += (v[j].x * v[j].x + v[j].y * v[j].y) + (v[j].z * v[j].z + v[j].w * v[j].w); }
                const float rstd = 1.0f / sqrtf(wave_sum(s) * (1.f / D) + EPS);
                GAS v2u* o8 = (GAS v2u*)(HN + (size_t)m * D) + lane;
#pragma unroll
                for (int j = 0; j < 4; ++j) { const int c = 4 * lane + 256 * j; const f32x4 gg = *(const f32x4*)(A_IN(20) + c), s0 = *(LAS f32x4*)(mv + b * 2048 + c), s1 = *(LAS f32x4*)(mv + b * 2048 + 1024 + c);
                    const f32x4 y = v[j] * rstd * gg * (s1 + 1.0f) + s0; v2u w; w.x = pk2(y.x, y.y); w.y = pk2(y.z, y.w); o8[64 * j] = w; } }
            asm volatile("s_waitcnt vmcnt(0)" ::: "memory");
            int mr = m0 + fr * NGW; const bool mok = mr < M; mr = mok ? mr : M - 1;
            f32x4 acc = {0.f, 0.f, 0.f, 0.f}; const bf16* arow = HN + (size_t)mr * D + 8 * fq;
#pragma unroll 8
            for (int ks = 0; ks < 32; ++ks) { const bf16x8 af = *(const GAS bf16x8*)(arow + 32 * ks); const bf16x8 wf = *(const LAS bf16x8*)(wfb + fr * RSW + (32 * ks + 8 * fq) * 2);
                acc = __builtin_amdgcn_mfma_f32_16x16x32_bf16(wf, af, acc, 0, 0, 0); }
            const f32x4 bb = *(const f32x4*)(A_IN(3) + 4 * fq); const int srow = mr & 8191, b = mr >> 13;
            if (mok)
#pragma unroll
            for (int j = 0; j < 4; ++j) { const float x = acc[j] + bb[j]; const float lf = fminf(x, 0.f) - __logf(1.0f + __expf(-fabsf(x))); LOGF[((size_t)(b * 16 + 4 * fq + j) << 13) + srow] = lf; }
        }
        __syncthreads();
    }
    PHASE_END(2)
    PHASE_BEGIN(3)
    { pg8::Gemm g{HN, WFI, M, 4096, D}; pg8::StaticOrder S; S.init(M, 4096, G, bx);
      pg8::EpiFoxIn E{QB, KB, VB, GB, LOGF, A_IN(4), A_IN(5), A_IN(3)};
      pg8::gemm_phase<pg8::EpiFoxIn, pg8::StaticOrder, true, true>(ldsl, g, S, E);
      { const int nwg = (M / 256) * 16, rem = nwg % G;
        if (rem != 0 && bx >= rem) { LAS float* scr = (LAS float*)(ldsl + wave * 16640);
            for (int it = CV_G2 + (bx - rem) * NWAVES + wave; it < CV_G3; it += (G - rem) * NWAVES) CONVERT_ITEM(it, scr); }
        else if (rem == 0) { LAS float* scr = (LAS float*)(ldsl + wave * 16640); for (int it = CV_G2 + gw; it < CV_G3; it += NGW) CONVERT_ITEM(it, scr); } } }
    PHASE_END(3)
    PHASE_BEGIN(4)
    for (int bh = vcu; bh < 64; bh += G) {
        LAS float* Fl = (LAS float*)ldsl; LAS float* wt = (LAS float*)(ldsl + 32768);
        const float* src = LOGF + (size_t)bh * SEQ + tid * 16; f32x4 v[4];
#pragma unroll
        for (int j = 0; j < 4; ++j) v[j] = *(const f32x4*)(src + 4 * j);
        float p[16]; float run = 0.f;
#pragma unroll
        for (int j = 0; j < 4; ++j) { run += v[j].x; p[4 * j] = run; run += v[j].y; p[4 * j + 1] = run; run += v[j].z; p[4 * j + 2] = run; run += v[j].w; p[4 * j + 3] = run; }
        float inc = run;
#pragma unroll
        for (int o = 1; o < 64; o <<= 1) { const float t = __shfl_up(inc, o); if (lane >= o) inc += t; }
        if (lane == 63) wt[wave] = inc;
        __syncthreads();
        float offs = inc - run;
        for (int w = 0; w < wave; ++w) offs += wt[w];
#pragma unroll
        for (int j = 0; j < 4; ++j) { f32x4 o; o.x = (offs + p[4 * j]) * 1.4426950409f; o.y = (offs + p[4 * j + 1]) * 1.4426950409f; o.z = (offs + p[4 * j + 2]) * 1.4426950409f; o.w = (offs + p[4 * j + 3]) * 1.4426950409f;
            *(f32x4*)(FB + (size_t)bh * SEQ + tid * 16 + 4 * j) = o; *(LAS f32x4*)(Fl + tid * 16 + 4 * j) = o; }
        __syncthreads();
        if (tid < 32) {
            float gq = 0.f, gk = 0.f;
            for (int i = 0; i < 64; ++i) { gq = fmaxf(gq, fabsf(A_IN(4)[i])); gk = fmaxf(gk, fabsf(A_IN(5)[i])); }
            const float thr = 40.0f + 2.0f * 64.0f * 0.18033688f * gq * gk;
            const int qb = tid, q0 = 256 * qb; int t0 = 4 * qb; const float fq0 = Fl[q0];
            while (t0 > 0 && !(Fl[64 * t0 - 1] - fq0 > thr)) t0 -= 2;
            T0[bh * 32 + qb] = t0;
        }
        __syncthreads();
    }
    PHASE_END(4)
    PHASE_BEGIN(5)
    { static_assert((long)WS_K - (long)WS_Q == 2 * attn_body::K_OFF && (long)WS_V - (long)WS_Q == 2 * attn_body::V_OFF && (long)WS_G - (long)WS_Q == 2 * attn_body::G_OFF && (long)WS_HN - (long)WS_Q == 2 * attn_body::O_OFF, "attention operand offsets");
      const attn_body::AttnTensors AT{(attn_body::bf16*)QB, FB, T0};
      LAS int* cntw = (LAS int*)(ldsl + 120832); LAS int* tot = cntw + 512; LAS int* sorted = tot + 64; LAS int* mine = sorted + 2048;
      cntw[tid] = 0;
      __syncthreads();
      int key[4];
#pragma unroll
      for (int j = 0; j < 4; ++j) { const int un = 4 * tid + j; const int nt = 4 * (un & 31) + 4 - T0[un]; key[j] = 64 - (nt >> 1); atomicAdd((int*)(cntw + wave * 64 + key[j]), 1); }
      __syncthreads();
      if (tid < 64) { int run = 0; for (int w = 0; w < 8; ++w) { const int c = cntw[w * 64 + tid]; cntw[w * 64 + tid] = run; run += c; } tot[tid] = run; }
      __syncthreads();
      if (tid == 0) { int run = 0; for (int k = 0; k < 64; ++k) { const int c = tot[k]; tot[k] = run; run += c; } }
      __syncthreads();
      { int rank[4] = {0, 0, 0, 0}; const unsigned long long lt = (1ull << lane) - 1ull;
        for (int b = 0; b < 64; ++b) {
            const unsigned long long m0 = __ballot(key[0] == b), m1 = __ballot(key[1] == b), m2 = __ballot(key[2] == b), m3 = __ballot(key[3] == b);
            if ((m0 | m1 | m2 | m3) == 0ull) continue;
            const int lower = __popcll(m0 & lt) + __popcll(m1 & lt) + __popcll(m2 & lt) + __popcll(m3 & lt);
            int same = 0;
#pragma unroll
            for (int j = 0; j < 4; ++j) if (key[j] == b) { rank[j] = lower + same; ++same; }
        }
#pragma unroll
        for (int j = 0; j < 4; ++j) sorted[tot[key[j]] + cntw[wave * 64 + key[j]] + rank[j]] = 4 * tid + j; }
      __syncthreads();
      const int nrounds = (2048 + G - 1) / G; int nmine = 0;
      for (int r = 0; r < nrounds; ++r) { const int j = r * G + ((r & 1) ? (G - 1 - vcu) : vcu); if (j < 2048) { if (tid == 0) { const int un = sorted[j]; mine[nmine] = un | (T0[un] << 16); } ++nmine; } }
      __syncthreads();
      const attn_body::StaticOrder S((const int*)mine, nmine);
      attn_body::attn_phase<attn_body::StaticOrder>((char*)lds, AT, S); }
    PHASE_END(5)
    PHASE_BEGIN(6)
    { pg8::Gemm g{HN, WFO, M, D, D}; pg8::StaticOrder S; S.init(M, D, G, bx);
      pg8::EpiRes<true> E{x_in, X1H, MODV(0, 2)};
      pg8::gemm_phase<pg8::EpiRes<true>, pg8::StaticOrder, true, true>(ldsl, g, S, E); }
    PHASE_END(6)
#define FFN_BLOCK(l, XIN, XOUT, PB) \
    PHASE_BEGIN(PB) \
    for (int m = gw; m < M; m += NGW) { const int b = m >> 13; norm_row_bf16((XIN) + (size_t)m * D, A_IN(21) + (l) * D, MODV(l, 3) + b * 6144, MODV(l, 4) + b * 6144, HN + (size_t)m * D, lane); } \
    PHASE_END(PB) \
    PHASE_BEGIN((PB) + 1) \
    { pg8::Gemm g{HN - 2 * D, (const bf16*)(ws + ((l) ? WS_WUP1 : WS_WUP0)), 136 * 256, 5632, D}; pg8::StaticOrder S; S.init(136 * 256, 5632, G, bx); \
      pg8::EpiFfnUp E{ACT, A_IN(15) + (size_t)(l) * 3 * 5632, A_IN(16) + (size_t)(l) * 5632}; \
      pg8::gemm_phase<pg8::EpiFfnUp, pg8::StaticOrder, true, true, true>(ldsl, g, S, E); \
      if ((l) == 0) { const int rem = (136 * 22) % G; LAS float* scr = (LAS float*)(ldsl + wave * 16640);     \
        if (rem != 0) { if (bx >= rem) for (int it = CV_G3 + (bx - rem) * NWAVES + wave; it < CV_END; it += (G - rem) * NWAVES) CONVERT_ITEM(it, scr); } \
        else for (int it = CV_G3 + gw; it < CV_END; it += NGW) CONVERT_ITEM(it, scr); } } \
    PHASE_END((PB) + 1) \
    PHASE_BEGIN((PB) + 2) \
    { pg8::Gemm g{ACT, (const bf16*)(ws + ((l) ? WS_WDN1 : WS_WDN0)), M, D, DFF}; pg8::StaticOrder S; S.init(M, D, G, bx); \
      pg8::EpiRes<false> E{(XIN), (XOUT), MODV(l, 5)}; \
      pg8::gemm_phase<pg8::EpiRes<false>, pg8::StaticOrder, true, true>(ldsl, g, S, E); } \
    PHASE_END((PB) + 2)
    FFN_BLOCK(0, X1H, X2H, 7)
    PHASE_BEGIN(10)
    for (int m = gw; m < M; m += NGW) { const int b = m >> 13; norm_row_bf16(X2H + (size_t)m * D, A_IN(20) + D, MODV(1, 0) + b * 6144, MODV(1, 1) + b * 6144, HN + (size_t)m * D, lane); }
    PHASE_END(10)
    PHASE_BEGIN(11)
    { pg8::Gemm g{HN, WSI, M, 4096, D}; pg8::StaticOrder S; S.init(M, 4096, G, bx);
      pg8::EpiSguIn E{UB, VS, A_IN(8), STATS};
      pg8::gemm_phase<pg8::EpiSguIn, pg8::StaticOrder, true, true>(ldsl, g, S, E); }
    PHASE_END(11)
    PHASE_BEGIN(12)
    {
        constexpr int RS = 272, OFF_B = 128 * RS, OFF_ST = OFF_B + 256 * RS;
        const int g = bx & 7;
        for (int i = tid; i < 128 * 16; i += 512) { const int r = i >> 4, c = i & 15; *(LAS v4u*)(ldsl + r * RS + c * 16) = *(const v4u*)(WSM + ((size_t)g * 128 + r) * 128 + c * 8); }
        const int cc = tid & 31; float gn[8], bs[8];
#pragma unroll
        for (int e = 0; e < 8; ++e) { gn[e] = A_IN(9)[g * 256 + 8 * cc + e]; bs[e] = A_IN(10)[g * 256 + 8 * cc + e]; }
        const int fr = lane & 15, fq = lane >> 4, wm = wave >> 2, wn = wave & 3;
        LAS f32x2* ST = (LAS f32x2*)(ldsl + OFF_ST);
        v4u va[4], vb[4]; f32x4 sq[4];
#define MIX_LOAD(IDX) do { const size_t rb_ = (size_t)((IDX) >> 3) * 128; \
            _Pragma("unroll") for (int it = 0; it < 4; ++it) { const int sp = (it * 512 + tid) >> 5; const bf16* vp = VS + (rb_ + 2 * sp) * SGW + g * 256 + 8 * cc; va[it] = *(const v4u*)vp; vb[it] = *(const v4u*)(vp + SGW); } \
            { const float* sp_ = STATS + (rb_ + (tid >> 2)) * 64 + (tid & 3) * 16; _Pragma("unroll") for (int j = 0; j < 4; ++j) sq[j] = *(const f32x4*)(sp_ + 4 * j); } } while (0)
        float bsv4[4];
#pragma unroll
        for (int m = 0; m < 4; ++m) bsv4[m] = A_IN(12)[g * 128 + 64 * wm + 16 * m + fr];
        int idx = bx; if (idx < 2048) MIX_LOAD(idx);
        for (; idx < 2048; idx += G) {
            const int bn = idx >> 3; const size_t rowbase = (size_t)bn * 128;
            { float s1 = 0.f, s2 = 0.f;
#pragma unroll
              for (int j = 0; j < 4; ++j) { s1 += sq[j].x + sq[j].z; s2 += sq[j].y + sq[j].w; }
              s1 += __shfl_xor(s1, 1); s1 += __shfl_xor(s1, 2); s2 += __shfl_xor(s2, 1); s2 += __shfl_xor(s2, 2);
              if ((tid & 3) == 0) { const float mu = s1 * (1.f / SGW); const float var = fmaxf(s2 * (1.f / SGW) - mu * mu, 0.f); ST[tid >> 2] = (f32x2){mu, 1.0f / sqrtf(var + EPS)}; } }
            __syncthreads();
#pragma unroll
            for (int it = 0; it < 4; ++it) { const int sp = (it * 512 + tid) >> 5; const v4u a = va[it], b = vb[it]; const f32x2 st0 = ST[2 * sp], st1 = ST[2 * sp + 1];
#pragma unroll
                for (int e = 0; e < 8; ++e) { const unsigned wa = a[e >> 1], wb = b[e >> 1]; const float x0 = (e & 1) ? bfhi(wa) : bflo(wa), x1 = (e & 1) ? bfhi(wb) : bflo(wb);
                    const float y0 = (x0 - st0.x) * st0.y * gn[e] + bs[e], y1 = (x1 - st1.x) * st1.y * gn[e] + bs[e];
                    *(LAS unsigned*)(ldsl + OFF_B + (8 * cc + e) * RS + ((((sp >> 2) ^ (cc & 7)) << 2) | (sp & 3)) * 4) = pk2(y0, y1); } }
            __syncthreads();
            { const int nidx = idx + G; if (nidx < 2048) MIX_LOAD(nidx); }
            f32x4 acc[4][4];
#pragma unroll
            for (int m = 0; m < 4; ++m)
#pragma unroll
                for (int n = 0; n < 4; ++n) acc[m][n] = (f32x4){0.f, 0.f, 0.f, 0.f};
#pragma unroll
            for (int kk = 0; kk < 4; ++kk) {
                if (wm == 0 && kk >= 2) continue;
                bf16x8 Af[4], Bf[4];
#pragma unroll
                for (int m = 0; m < 4; ++m) Af[m] = *(const LAS bf16x8*)(ldsl + (64 * wm + 16 * m + fr) * RS + (32 * kk + 8 * fq) * 2);
#pragma unroll
                for (int n = 0; n < 4; ++n) { const int crow = 64 * wn + 32 * (n >> 1) + 8 * (fr >> 2) + 4 * (n & 1) + (fr & 3); Bf[n] = *(const LAS bf16x8*)(ldsl + OFF_B + crow * RS + (((4 * kk + fq) ^ ((crow >> 3) & 7)) << 4)); }
#pragma unroll
                for (int m = 0; m < 4; ++m)
#pragma unroll
                    for (int n = 0; n < 4; ++n) acc[m][n] = __builtin_amdgcn_mfma_f32_16x16x32_bf16(Bf[n], Af[m], acc[m][n], 0, 0, 0);
            }
            v4u uu[4][2];
#pragma unroll
            for (int m = 0; m < 4; ++m)
#pragma unroll
                for (int p = 0; p < 2; ++p) uu[m][p] = *(const v4u*)(UB + (rowbase + 64 * wm + 16 * m + fr) * SGW + g * 256 + 64 * wn + 32 * p + 8 * fq);
#pragma unroll
            for (int m = 0; m < 4; ++m) { const int t = 64 * wm + 16 * m + fr; const float bsv = bsv4[m];
#pragma unroll
                for (int p = 0; p < 2; ++p) { bf16* up = UB + (rowbase + t) * SGW + g * 256 + 64 * wn + 32 * p + 8 * fq; v4u o;
#pragma unroll
                    for (int e = 0; e < 4; ++e) { const f32x4 lo4 = acc[m][2 * p], hi4 = acc[m][2 * p + 1];
                        const float m0 = ((e < 2) ? lo4[2 * e] : hi4[2 * e - 4]) + bsv, m1 = ((e < 2) ? lo4[2 * e + 1] : hi4[2 * e - 3]) + bsv;
                        o[e] = pk2(pg8::gelu_tanh(bflo(uu[m][p][e])) * m0, pg8::gelu_tanh(bfhi(uu[m][p][e])) * m1); }
                    if (rep_ == (int)((REPMASK >> 12) & 1ull)) *(v4u*)up = o; } }
            __syncthreads();
        }
#undef MIX_LOAD
    }
    PHASE_END(12)
    PHASE_BEGIN(13)
    { pg8::Gemm g{UB, WSO, M, D, SGW}; pg8::StaticOrder S; S.init(M, D, G, bx);
      pg8::EpiRes<false> E{X2H, X1H, MODV(1, 2)};
      pg8::gemm_phase<pg8::EpiRes<false>, pg8::StaticOrder, true, true>(ldsl, g, S, E); }
    PHASE_END(13)
    FFN_BLOCK(1, X1H, X2H2, 14)
    PHASE_BEGIN(17)
    for (int m = gw; m < M; m += NGW) { const unsigned short* xrow = X2H2 + (size_t)m * D; const v4u a = __builtin_nontemporal_load((const GAS v4u*)(xrow + 8 * lane)), b = __builtin_nontemporal_load((const GAS v4u*)(xrow + 512 + 8 * lane)); float v[16]; float s = 0.f;
#pragma unroll
        for (int i = 0; i < 4; ++i) { v[2 * i] = pg8::h_lo(a[i]); v[2 * i + 1] = pg8::h_hi(a[i]); v[8 + 2 * i] = pg8::h_lo(b[i]); v[8 + 2 * i + 1] = pg8::h_hi(b[i]); }
#pragma unroll
        for (int i = 0; i < 16; ++i) s += v[i] * v[i];
        const float rstd = 1.0f / sqrtf(wave_sum(s) * (1.f / D) + EPS);
#pragma unroll
        for (int h = 0; h < 2; ++h)
#pragma unroll
            for (int q = 0; q < 2; ++q) { const int c = 512 * h + 8 * lane + 4 * q; const f32x4 gg = *(const f32x4*)(A_IN(22) + c);
                const f32x4 x4 = {v[8 * h + 4 * q], v[8 * h + 4 * q + 1], v[8 * h + 4 * q + 2], v[8 * h + 4 * q + 3]}; __builtin_nontemporal_store(x4 * rstd * gg, (GAS f32x4*)(out + (size_t)m * D + c)); } }
    PHASE_END(17)
}

#undef ws
#undef out
#undef x_in
#undef T0
#undef A_IN
extern "C" void kernel_launch(void* const* d_in, const int* in_sizes, int n_in, void* d_out, int out_size, void* d_ws, size_t ws_size, hipStream_t stream) {
    static int grid = 0;
    if (grid == 0) {
        if (n_in != 23 || in_sizes[0] != M * D || out_size != M * D || ws_size < WS_END) { fprintf(stderr, "kernel_launch: unexpected shapes/workspace (n_in %d, in0 %d, out %d, ws %zu); nothing launched\n", n_in, n_in > 0 ? in_sizes[0] : -1, out_size, ws_size); grid = -1; return; }
        int dev = 0, cus = 0, per_cu = 0;
        if (hipGetDevice(&dev) != hipSuccess || hipDeviceGetAttribute(&cus, hipDeviceAttributeMultiprocessorCount, dev) != hipSuccess) { grid = -1; return; }
        if (hipFuncSetAttribute((const void*)fwd_mega, hipFuncAttributeMaxDynamicSharedMemorySize, LDS_BYTES) != hipSuccess) { fprintf(stderr, "kernel_launch: hipFuncSetAttribute failed\n"); grid = -1; return; }
        if (hipOccupancyMaxActiveBlocksPerMultiprocessor(&per_cu, (const void*)fwd_mega, NWAVES * 64, LDS_BYTES) != hipSuccess || per_cu < 1) { fprintf(stderr, "kernel_launch: occupancy query says %d blocks per CU\n", per_cu); per_cu = 1; }
        (void)hipGetLastError();
        grid = cus;
        if (grid % 8 != 0) grid -= grid % 8;
    }
    if (grid <= 0) return;
    if (hipMemsetAsync((char*)d_ws + WS_CTL, 0, CTL_ZERO_BYTES, stream) != hipSuccess) { fprintf(stderr, "kernel_launch: hipMemsetAsync failed\n"); return; }
    Args a{};
    for (int i = 0; i < 23; ++i) a.in[i] = (const float*)d_in[i];
    a.out = (float*)d_out; a.ws = (unsigned char*)d_ws; a.ph_lo = 0; a.ph_hi = 1000;
    void* kargs[] = {&a};
    hipError_t e = hipLaunchCooperativeKernel((const void*)fwd_mega, dim3(grid), dim3(NWAVES * 64), kargs, LDS_BYTES, stream);
    if (e != hipSuccess) fprintf(stderr, "kernel_launch: cooperative launch failed: %s (grid %d)\n", hipGetErrorString(e), grid);
}
```

```cpp
#include <hip/hip_runtime.h>
#include <hip/hip_cooperative_groups.h>
#include <cstdio>
#include <cstdint>
namespace pg8 {
#define PG8_LAS __attribute__((address_space(3)))
typedef unsigned short bf16_t;
typedef short bf16x8 __attribute__((ext_vector_type(8)));
typedef float f32x4 __attribute__((ext_vector_type(4)));
typedef unsigned u32x4 __attribute__((ext_vector_type(4)));
constexpr int BM = 256, BK = 64, HALF = 128, HTB = HALF * BK * 2  , STAGE_BYTES = 8 * HTB, NXCD = 8, WGM = 8;

__host__ __device__ __forceinline__ int lds_byte(int r, int c) { const int st = (r >> 4) * 2 + (c >> 5), rr = r & 15, cc = c & 31, ob = rr * 64 + cc * 2; return st * 1024 + (ob ^ (((ob >> 9) & 1) << 5)); }
__host__ __device__ __forceinline__ void stage_rc(int b, int& R, int& C) { const int st = b / 1024, sb = b % 1024, swz = sb ^ (((sb >> 9) & 1) << 5); R = (st >> 1) * 16 + swz / 64; C = (st & 1) * 32 + (swz % 64) / 2; }
__host__ __device__ __forceinline__ int perm32(int rho) { const int n = rho >> 4, i = rho & 15; return 8 * (i >> 2) + 4 * n + (i & 3); }

struct Unit { int pm, pn; };
struct Gemm { const bf16_t* A; const bf16_t* Bt; int M, N, K; };

struct StaticOrder {
    int nM, nN, nwg, G, c;
    __host__ __device__ void init(int M, int N, int G_, int c_) { nM = M / BM; nN = N / BM; nwg = nM * nN; G = G_; c = c_; }
    __host__ __device__ bool next(int i, Unit& u) const {
        const long L = (long)i * G + c; if (L >= nwg) return false;
        int wgid = (int)L; { const int q = nwg / NXCD, r = nwg % NXCD, xcd = wgid % NXCD, off = wgid / NXCD; wgid = (xcd < r ? xcd * (q + 1) : r * (q + 1) + (xcd - r) * q) + off; }
        const int nig = WGM * nN, gid = wgid / nig, fm = gid * WGM, gsz = (nM - fm) < WGM ? (nM - fm) : WGM;
        u.pm = fm + ((wgid % nig) % gsz); u.pn = (wgid % nig) / gsz; return true;
    }
    __device__ __forceinline__ void a_ready(const Unit&) const {}
    __device__ __forceinline__ void done(const Unit&) const {}
};

__device__ __forceinline__ unsigned cvt_pk_bf16(float lo, float hi) { unsigned r; asm volatile("v_cvt_pk_bf16_f32 %0, %1, %2" : "=v"(r) : "v"(lo), "v"(hi)); return r; }
typedef _Float16 f16x2_t __attribute__((ext_vector_type(2))); typedef float f32x2c_t __attribute__((ext_vector_type(2)));
__device__ __forceinline__ unsigned pk_h2(float lo, float hi) { const f32x2c_t v = {lo, hi}; return __builtin_bit_cast(unsigned, __builtin_convertvector(v, f16x2_t)); }
__device__ __forceinline__ float h_lo(unsigned w) { return (float)__builtin_bit_cast(f16x2_t, w)[0]; }
__device__ __forceinline__ float h_hi(unsigned w) { return (float)__builtin_bit_cast(f16x2_t, w)[1]; }
__device__ __forceinline__ float fast_sigmoid(float x) { return __builtin_amdgcn_rcpf(1.0f + __builtin_amdgcn_exp2f(-1.4426950409f * x)); }
__device__ __forceinline__ float gelu_tanh(float x) { const float t = x * (1.0f + 0.044715f * x * x) * 2.302208198f; return x * __builtin_amdgcn_rcpf(1.0f + __builtin_amdgcn_exp2f(-t)); }
__device__ __forceinline__ void conv_taps(float& acc, float x, float xp, float w1, float w0) {
    asm("s_nop 1\n\t"
        "v_fmac_f32_dpp %0, %1, %3 row_shr:1 row_mask:0xf bank_mask:0xf bound_ctrl:1\n\t"
        "v_fmac_f32_dpp %0, %2, %3 row_shl:15 row_mask:0xf bank_mask:0xf bound_ctrl:1\n\t"
        "v_fmac_f32_dpp %0, %1, %4 row_shr:2 row_mask:0xf bank_mask:0xf bound_ctrl:1\n\t"
        "v_fmac_f32_dpp %0, %2, %4 row_shl:14 row_mask:0xf bank_mask:0xf bound_ctrl:1"
        : "+v"(acc) : "v"(x), "v"(xp), "v"(w1), "v"(w0));
}

struct EpiFoxIn {
    static constexpr bool PERM = true, AFTER_DRAIN = false;
    bf16_t *Q, *Kb, *V, *G; float* LOGF; const float *qg, *kg, *bfg;
    __device__ __forceinline__ void operator()(const f32x4 (&acc)[2][2][4][2], const Unit& u, int wr, int wc, int fr, int fq) const {
        const int row0 = u.pm * BM + wr * 64 + fr; const int pn = u.pn;
        if (pn < 8) {
            const bool isq = pn < 4; const float* gn = isq ? qg : kg; const float post = isq ? 0.18033688011112042f : 1.0f;
            bf16_t* base = (isq ? Q : Kb) + ((pn & 3) * 4 + wc) * 64 + 8 * fq;
            f32x4 gv[2][2];
#pragma unroll
            for (int bj = 0; bj < 2; ++bj)
#pragma unroll
                for (int n = 0; n < 2; ++n) gv[bj][n] = *(const f32x4*)(gn + 32 * bj + 8 * fq + 4 * n) * post;
#pragma unroll
            for (int ai = 0; ai < 2; ++ai)
#pragma unroll
                for (int m = 0; m < 4; ++m) {
                    float ss = 0.f;
#pragma unroll
                    for (int bj = 0; bj < 2; ++bj)
#pragma unroll
                        for (int n = 0; n < 2; ++n) { const f32x4 x = acc[ai][bj][m][n]; ss += (x[0] * x[0] + x[1] * x[1]) + (x[2] * x[2] + x[3] * x[3]); }
                    ss += __shfl_xor(ss, 16); ss += __shfl_xor(ss, 32);
                    const float r = __builtin_amdgcn_rsqf(ss * (1.0f / 64.0f) + 1e-6f);
                    bf16_t* rowp = base + (size_t)(row0 + ai * HALF + m * 16) * 1024;
#pragma unroll
                    for (int bj = 0; bj < 2; ++bj) { const f32x4 v0 = acc[ai][bj][m][0] * r * gv[bj][0], v1 = acc[ai][bj][m][1] * r * gv[bj][1];
                        u32x4 w; w.x = cvt_pk_bf16(v0[0], v0[1]); w.y = cvt_pk_bf16(v0[2], v0[3]); w.z = cvt_pk_bf16(v1[0], v1[1]); w.w = cvt_pk_bf16(v1[2], v1[3]);
                        *(u32x4*)(rowp + 32 * bj) = w; }
                }
        } else if (pn < 16) {
            const bool isv = pn < 12; bf16_t* base = (isv ? V : G) + ((pn & 3) * 4 + wc) * 64 + 8 * fq;
#pragma unroll
            for (int ai = 0; ai < 2; ++ai)
#pragma unroll
                for (int m = 0; m < 4; ++m) { bf16_t* rowp = base + (size_t)(row0 + ai * HALF + m * 16) * 1024;
#pragma unroll
                    for (int bj = 0; bj < 2; ++bj) { f32x4 v0 = acc[ai][bj][m][0], v1 = acc[ai][bj][m][1];
                        if (!isv) {
#pragma unroll
                            for (int j = 0; j < 4; ++j) { v0[j] = fast_sigmoid(v0[j]); v1[j] = fast_sigmoid(v1[j]); } }
                        u32x4 w; w.x = cvt_pk_bf16(v0[0], v0[1]); w.y = cvt_pk_bf16(v0[2], v0[3]); w.z = cvt_pk_bf16(v1[0], v1[1]); w.w = cvt_pk_bf16(v1[2], v1[3]);
                        *(u32x4*)(rowp + 32 * bj) = w; } }
        } else {
            if (wc == 0 && fq < 2) {
#pragma unroll
                for (int n = 0; n < 2; ++n) { const f32x4 bb = *(const f32x4*)(bfg + 8 * fq + 4 * n);
#pragma unroll
                    for (int ai = 0; ai < 2; ++ai)
#pragma unroll
                        for (int m = 0; m < 4; ++m) { const int row = row0 + ai * HALF + m * 16, b = row >> 13, s = row & 8191;
#pragma unroll
                            for (int j = 0; j < 4; ++j) { const float x = acc[ai][0][m][n][j] + bb[j]; const float lf = fminf(x, 0.f) - __logf(1.0f + __expf(-fabsf(x)));
                                LOGF[((size_t)(b * 16 + 8 * fq + 4 * n + j) << 13) + s] = lf; } } }
            }
        }
    }
};
template <bool BASE_F32> struct EpiRes {
    static constexpr bool PERM = true, AFTER_DRAIN = false;
    const void* base; unsigned short* out; const float* gate;
    __device__ __forceinline__ void operator()(const f32x4 (&acc)[2][2][4][2], const Unit& u, int wr, int wc, int fr, int fq) const {
        const float* gb = gate + (u.pm >> 5) * 6144; const int col0 = u.pn * BM + wc * 32 + 8 * fq;
        f32x4 gv[2][2];
#pragma unroll
        for (int bj = 0; bj < 2; ++bj)
#pragma unroll
            for (int n = 0; n < 2; ++n) gv[bj][n] = *(const f32x4*)(gb + col0 + bj * HALF + 4 * n);
#pragma unroll
        for (int ai = 0; ai < 2; ++ai) { const size_t off0 = (size_t)(u.pm * BM + ai * HALF + wr * 64 + fr) * 1024 + col0;
            f32x4 bs[4][2][2];
            if (BASE_F32) {
#pragma unroll
                for (int m = 0; m < 4; ++m)
#pragma unroll
                    for (int bj = 0; bj < 2; ++bj)
#pragma unroll
                        for (int n = 0; n < 2; ++n) bs[m][bj][n] = *(const f32x4*)((const float*)base + off0 + (size_t)m * 16 * 1024 + bj * HALF + 4 * n);
            } else {
                u32x4 bh[4][2];
#pragma unroll
                for (int m = 0; m < 4; ++m)
#pragma unroll
                    for (int bj = 0; bj < 2; ++bj) bh[m][bj] = *(const u32x4*)((const unsigned short*)base + off0 + (size_t)m * 16 * 1024 + bj * HALF);
#pragma unroll
                for (int m = 0; m < 4; ++m)
#pragma unroll
                    for (int bj = 0; bj < 2; ++bj) { bs[m][bj][0] = (f32x4){h_lo(bh[m][bj].x), h_hi(bh[m][bj].x), h_lo(bh[m][bj].y), h_hi(bh[m][bj].y)}; bs[m][bj][1] = (f32x4){h_lo(bh[m][bj].z), h_hi(bh[m][bj].z), h_lo(bh[m][bj].w), h_hi(bh[m][bj].w)}; }
            }
#pragma unroll
            for (int m = 0; m < 4; ++m)
#pragma unroll
                for (int bj = 0; bj < 2; ++bj) { const f32x4 o0 = bs[m][bj][0] + gv[bj][0] * acc[ai][bj][m][0], o1 = bs[m][bj][1] + gv[bj][1] * acc[ai][bj][m][1];
                    u32x4 w; w.x = pk_h2(o0[0], o0[1]); w.y = pk_h2(o0[2], o0[3]); w.z = pk_h2(o1[0], o1[1]); w.w = pk_h2(o1[2], o1[3]);
                    *(u32x4*)(out + off0 + (size_t)m * 16 * 1024 + bj * HALF) = w; }
            asm volatile("" ::: "memory"); }
    }
};
struct EpiSguIn {
    static constexpr bool PERM = true, AFTER_DRAIN = false;
    bf16_t *U, *V; const float* bias; float* stats;
    __device__ __forceinline__ void operator()(const f32x4 (&acc)[2][2][4][2], const Unit& u, int wr, int wc, int fr, int fq) const {
        const int pn = u.pn; const bool isv = pn >= 8; const int row0 = u.pm * BM + wr * 64 + fr;
        const int bcol0 = pn * BM + wc * 32 + 8 * fq; bf16_t* base = (isv ? V : U) + ((pn & 7) * BM + wc * 32 + 8 * fq);
        f32x4 bv[2][2];
#pragma unroll
        for (int bj = 0; bj < 2; ++bj)
#pragma unroll
            for (int n = 0; n < 2; ++n) bv[bj][n] = *(const f32x4*)(bias + bcol0 + bj * HALF + 4 * n);
#pragma unroll
        for (int ai = 0; ai < 2; ++ai)
#pragma unroll
            for (int m = 0; m < 4; ++m) { const int row = row0 + ai * HALF + m * 16; bf16_t* rowp = base + (size_t)row * 2048; float s1 = 0.f, s2 = 0.f;
#pragma unroll
                for (int bj = 0; bj < 2; ++bj) { f32x4 v0 = acc[ai][bj][m][0] + bv[bj][0], v1 = acc[ai][bj][m][1] + bv[bj][1];
                    if (isv) { for (int j = 0; j < 4; ++j) { v0[j] = gelu_tanh(v0[j]); v1[j] = gelu_tanh(v1[j]); } }
                    s1 += ((v0[0] + v0[1]) + (v0[2] + v0[3])) + ((v1[0] + v1[1]) + (v1[2] + v1[3]));
                    s2 += ((v0[0] * v0[0] + v0[1] * v0[1]) + (v0[2] * v0[2] + v0[3] * v0[3])) + ((v1[0] * v1[0] + v1[1] * v1[1]) + (v1[2] * v1[2] + v1[3] * v1[3]));
                    u32x4 w; w.x = cvt_pk_bf16(v0[0], v0[1]); w.y = cvt_pk_bf16(v0[2], v0[3]); w.z = cvt_pk_bf16(v1[0], v1[1]); w.w = cvt_pk_bf16(v1[2], v1[3]);
                    *(u32x4*)(rowp + bj * HALF) = w; }
                if (isv) { s1 += __shfl_xor(s1, 16); s1 += __shfl_xor(s1, 32); s2 += __shfl_xor(s2, 16); s2 += __shfl_xor(s2, 32);
                    if (fq == 0) { typedef float f32x2v __attribute__((ext_vector_type(2))); *(f32x2v*)(stats + ((size_t)row * 32 + (pn - 8) * 4 + wc) * 2) = (f32x2v){s1, s2}; } } }
    }
};
struct EpiFfnUp {
    static constexpr bool PERM = true, AFTER_DRAIN = false;
    bf16_t* ACT; const float *cw, *cb;
    __device__ __forceinline__ void operator()(const f32x4 (&acc)[2][2][4][2], const Unit& u, int wr, int wc, int fr, int fq) const {
        const int b = u.pm / 34, pmb = u.pm % 34; const int ch0 = u.pn * 128 + wc * 32 + 8 * fq;
        typedef unsigned u32x2v __attribute__((ext_vector_type(2)));
        u32x2v pk[2][4];
#pragma unroll
        for (int n = 0; n < 2; ++n) {
            const float* cwp = cw + ch0 + 4 * n; const float* cbp = cb + ch0 + 4 * n;
            const f32x4 w0g = *(const f32x4*)(cwp), w1g = *(const f32x4*)(cwp + 5632), w2g = *(const f32x4*)(cwp + 2 * 5632), bg = *(const f32x4*)(cbp);
            const f32x4 w0v = *(const f32x4*)(cwp + 2816), w1v = *(const f32x4*)(cwp + 5632 + 2816), w2v = *(const f32x4*)(cwp + 2 * 5632 + 2816), bvv = *(const f32x4*)(cbp + 2816);
#pragma unroll
            for (int ai = 0; ai < 2; ++ai) { const int j = 2 * ai + wr; const bool first = (pmb == 0) && (j == 0); const int tb = 248 * pmb + 62 * j - 2 + fr;
                f32x4 pg, pv;
#pragma unroll
                for (int m = 0; m < 4; ++m) { f32x4 g = acc[ai][0][m][n], v = acc[ai][1][m][n];
                    if (m == 0) { if (first && fr < 2) { g = (f32x4){0.f, 0.f, 0.f, 0.f}; v = g; } pg = g; pv = v; }
                    f32x4 r;
#pragma unroll
                    for (int c = 0; c < 4; ++c) {
                        float cg = w2g[c] * g[c] + bg[c]; conv_taps(cg, g[c], pg[c], w1g[c], w0g[c]);
                        float cv = w2v[c] * v[c] + bvv[c]; conv_taps(cv, v[c], pv[c], w1v[c], w0v[c]);
                        r[c] = cg * cv * fast_sigmoid(cg); }
                    pg = g; pv = v;
                    u32x2v w; w.x = cvt_pk_bf16(r[0], r[1]); w.y = cvt_pk_bf16(r[2], r[3]);
                    if (n == 0) pk[ai][m] = w;
                    else { const int t = tb + 16 * m; if ((m > 0 || fr >= 2) && t < 8192) { u32x4 o; o.x = pk[ai][m].x; o.y = pk[ai][m].y; o.z = w.x; o.w = w.y;
                            *(u32x4*)(ACT + ((size_t)b * 8192 + t) * 2816 + ch0) = o; } }
                } }
        }
    }
};

template <class Epi, class Sched, bool ALIGN_EPI = false, bool SP2 = false, bool OVL = false>
__device__ __forceinline__ void gemm_phase(PG8_LAS unsigned char* lds, const Gemm g, const Sched& S, const Epi& E) {
    const int tid = threadIdx.x, wid = __builtin_amdgcn_readfirstlane(tid >> 6), lane = tid & 63, wr = wid >> 2, wc = wid & 3, fr = lane & 15, fq = lane >> 4;
    const int K = g.K, nt = K / BK;
    unsigned voffA[2], voffB[2];
#pragma unroll
    for (int i = 0; i < 2; ++i) { int R, C; stage_rc(tid * 16 + i * 8192, R, C); const int Rb = Epi::PERM ? ((R & ~31) + perm32(R & 31)) : R;
        { const int Ra = OVL ? (R - 2 * (R >> 6)) : R; voffA[i] = (unsigned)(Ra * K + C) * 2u; } voffB[i] = (unsigned)(Rb * K + C) * 2u; }
    const size_t kstep = (size_t)(BK * 2);
    const size_t hstep = (size_t)HALF * K * 2;
    const size_t tstep = 2 * hstep;
    const size_t hstepA = OVL ? (size_t)124 * K * 2 : hstep;
#define PG8_AOFF(pm) (OVL ? ((size_t)((pm) / 34) * 8192 + (size_t)((pm) % 34) * 248) * (size_t)K * 2 : (size_t)(pm) * tstep)
    const unsigned ldsw = (unsigned)wid * 1024u;
    const int aoff = lds_byte(wr * 64 + fr, fq * 8), boff = lds_byte(wc * 32 + fr, fq * 8);
#define PG8_SA(b, h) (((b) * 2 + (h)) * HTB)
#define PG8_SB(b, h) ((4 + (b) * 2 + (h)) * HTB)
#define PG8_STAGE(bufoff, gbase, voff) do { _Pragma("unroll") for (int _i = 0; _i < 2; ++_i) \
        __builtin_amdgcn_global_load_lds((const unsigned*)((const char*)(gbase) + (voff)[_i]), (PG8_LAS unsigned*)(lds + (bufoff) + ldsw + _i * 8192), 16, 0, 0); } while (0)
#define PG8_LDA(dst, b, h) do { _Pragma("unroll") for (int m = 0; m < 4; ++m) _Pragma("unroll") for (int k = 0; k < 2; ++k) dst[m][k] = *(const PG8_LAS bf16x8*)(lds + PG8_SA(b, h) + aoff + m * 2048 + k * 1024); } while (0)
#define PG8_LDB(dst, b, h) do { _Pragma("unroll") for (int n = 0; n < 2; ++n) _Pragma("unroll") for (int k = 0; k < 2; ++k) dst[n][k] = *(const PG8_LAS bf16x8*)(lds + PG8_SB(b, h) + boff + n * 2048 + k * 1024); } while (0)
#define PG8_MMA(ai, bj, At, Bt) do { __builtin_amdgcn_s_setprio(1); _Pragma("unroll") for (int m = 0; m < 4; ++m) _Pragma("unroll") for (int n = 0; n < 2; ++n) _Pragma("unroll") for (int k = 0; k < 2; ++k) \
        acc[ai][bj][m][n] = __builtin_amdgcn_mfma_f32_16x16x32_bf16(Bt[n][k], At[m][k], acc[ai][bj][m][n], 0, 0, 0); __builtin_amdgcn_s_setprio(0); } while (0)
#define PG8_WAIT_V(n) asm volatile("s_waitcnt vmcnt(" #n ")" ::: "memory")
#define PG8_WAIT_L(n) asm volatile("s_waitcnt lgkmcnt(" #n ")" ::: "memory")
#define PG8_BAR __builtin_amdgcn_s_barrier()
#define PG8_SCHED __builtin_amdgcn_sched_barrier(0)
    Unit cur, nxt; int ui = 0;
    if (!S.next(0, cur)) return;
    f32x4 acc[2][2][4][2];
#pragma unroll
    for (int a = 0; a < 2; ++a)
#pragma unroll
        for (int b = 0; b < 2; ++b)
#pragma unroll
            for (int m = 0; m < 4; ++m)
#pragma unroll
                for (int n = 0; n < 2; ++n) acc[a][b][m][n] = (f32x4){0.f, 0.f, 0.f, 0.f};
    bf16x8 At[4][2], B0[2][2], B1[2][2];
    const char* cA = (const char*)g.A + PG8_AOFF(cur.pm); const char* cB = (const char*)g.Bt + (size_t)cur.pn * tstep;
    S.a_ready(cur);
    if constexpr (SP2) {
        PG8_STAGE(PG8_SB(0, 0), cB, voffB); PG8_STAGE(PG8_SB(0, 1), cB + hstep, voffB); PG8_STAGE(PG8_SA(0, 0), cA, voffA); PG8_STAGE(PG8_SA(0, 1), cA + hstepA, voffA);
        if (wr == 1) PG8_BAR;
        PG8_WAIT_V(2); PG8_BAR;
        PG8_STAGE(PG8_SB(1, 0), cB + kstep, voffB); PG8_STAGE(PG8_SA(1, 0), cA + kstep, voffA); PG8_STAGE(PG8_SB(1, 1), cB + hstep + kstep, voffB);
        PG8_WAIT_V(6); PG8_BAR;
    } else {
        PG8_STAGE(PG8_SB(0, 0), cB, voffB); PG8_STAGE(PG8_SA(0, 0), cA, voffA); PG8_STAGE(PG8_SB(0, 1), cB + hstep, voffB); PG8_STAGE(PG8_SA(0, 1), cA + hstepA, voffA);
        if (wr == 1) PG8_BAR;
        PG8_WAIT_V(4); PG8_BAR;
        PG8_STAGE(PG8_SB(1, 0), cB + kstep, voffB); PG8_STAGE(PG8_SA(1, 0), cA + kstep, voffA); PG8_STAGE(PG8_SB(1, 1), cB + hstep + kstep, voffB);
        PG8_WAIT_V(6); PG8_BAR;
    }
    for (;;) {
        const bool has_next = S.next(ui + 1, nxt);
        const char* nA = has_next ? (const char*)g.A + PG8_AOFF(nxt.pm) : cA; const char* nB = has_next ? (const char*)g.Bt + (size_t)nxt.pn * tstep : cB;
        for (int t = 0; t < nt; t += 2) {
            const bool last = (t == nt - 2);
            const char* a1 = cA + (size_t)(t + 1) * kstep;
            const char* a2 = last ? nA : cA + (size_t)(t + 2) * kstep; const char* b2 = last ? nB : cB + (size_t)(t + 2) * kstep;
            const char* a3 = a2 + kstep; const char* b3 = b2 + kstep;
            if (last && has_next) S.a_ready(nxt);
            if constexpr (SP2) {
            PG8_LDB(B0, 0, 0); PG8_LDB(B1, 0, 1); PG8_SCHED; PG8_LDA(At, 0, 0); PG8_STAGE(PG8_SA(1, 1), a1 + hstepA, voffA);
            PG8_WAIT_V(8); PG8_WAIT_L(0); PG8_BAR; PG8_MMA(0, 0, At, B0); PG8_MMA(0, 1, At, B1); PG8_BAR; PG8_SCHED;
            PG8_LDA(At, 0, 1); PG8_STAGE(PG8_SB(0, 0), b2, voffB); PG8_STAGE(PG8_SB(0, 1), b2 + hstep, voffB); PG8_STAGE(PG8_SA(0, 0), a2, voffA);
            PG8_WAIT_V(8); PG8_WAIT_L(0); PG8_BAR; PG8_MMA(1, 0, At, B0); PG8_MMA(1, 1, At, B1); PG8_BAR; PG8_SCHED;
            PG8_LDB(B0, 1, 0); PG8_LDB(B1, 1, 1); PG8_SCHED; PG8_LDA(At, 1, 0); PG8_STAGE(PG8_SA(0, 1), a2 + hstepA, voffA);
            PG8_WAIT_V(8); PG8_WAIT_L(0); PG8_BAR; PG8_MMA(0, 0, At, B0); PG8_MMA(0, 1, At, B1); PG8_BAR; PG8_SCHED;
            PG8_LDA(At, 1, 1); PG8_STAGE(PG8_SB(1, 0), b3, voffB); PG8_STAGE(PG8_SB(1, 1), b3 + hstep, voffB); PG8_STAGE(PG8_SA(1, 0), a3, voffA);
            PG8_WAIT_V(8); PG8_WAIT_L(0); PG8_BAR; PG8_MMA(1, 0, At, B0); PG8_MMA(1, 1, At, B1); PG8_BAR; PG8_SCHED;
            } else {
            PG8_LDB(B0, 0, 0); PG8_SCHED; PG8_LDA(At, 0, 0); PG8_STAGE(PG8_SA(1, 1), a1 + hstepA, voffA);
            PG8_WAIT_L(8); PG8_BAR; PG8_WAIT_L(0); PG8_MMA(0, 0, At, B0); PG8_BAR; PG8_SCHED;
            PG8_LDB(B1, 0, 1); PG8_STAGE(PG8_SB(0, 0), b2, voffB);
            PG8_BAR; PG8_WAIT_L(0); PG8_MMA(0, 1, At, B1); PG8_BAR;
            PG8_LDA(At, 0, 1); PG8_STAGE(PG8_SA(0, 0), a2, voffA);
            PG8_BAR; PG8_WAIT_L(0); PG8_MMA(1, 0, At, B0); PG8_BAR; PG8_SCHED;
            PG8_STAGE(PG8_SB(0, 1), b2 + hstep, voffB);
            PG8_WAIT_V(6); PG8_BAR; PG8_MMA(1, 1, At, B1); PG8_BAR;
            PG8_LDB(B0, 1, 0); PG8_SCHED; PG8_LDA(At, 1, 0); PG8_STAGE(PG8_SA(0, 1), a2 + hstepA, voffA);
            PG8_WAIT_L(8); PG8_BAR; PG8_WAIT_L(0); PG8_MMA(0, 0, At, B0); PG8_BAR; PG8_SCHED;
            PG8_LDB(B1, 1, 1); PG8_STAGE(PG8_SB(1, 0), b3, voffB);
            PG8_BAR; PG8_WAIT_L(0); PG8_MMA(0, 1, At, B1); PG8_BAR;
            PG8_LDA(At, 1, 1); PG8_STAGE(PG8_SA(1, 0), a3, voffA);
            PG8_BAR; PG8_WAIT_L(0); PG8_MMA(1, 0, At, B0); PG8_BAR; PG8_SCHED;
            PG8_STAGE(PG8_SB(1, 1), b3 + hstep, voffB);
            PG8_WAIT_V(6); PG8_BAR; PG8_MMA(1, 1, At, B1); PG8_BAR;
            }
        }
        if constexpr (ALIGN_EPI) { if (wr == 0) PG8_BAR; }
        if constexpr (!Epi::AFTER_DRAIN) { E(acc, cur, wr, wc, fr, fq); S.done(cur); }
        if (!has_next) break;
#pragma unroll
        for (int a = 0; a < 2; ++a)
#pragma unroll
            for (int b = 0; b < 2; ++b)
#pragma unroll
                for (int m = 0; m < 4; ++m)
#pragma unroll
                    for (int n = 0; n < 2; ++n) acc[a][b][m][n] = (f32x4){0.f, 0.f, 0.f, 0.f};
        cur = nxt; cA = nA; cB = nB; ++ui;
        if constexpr (ALIGN_EPI) { if (wr == 1) PG8_BAR; }
    }
    PG8_WAIT_V(0);
    if constexpr (!ALIGN_EPI) { if (wr == 0) PG8_BAR; }
    PG8_BAR;
    if constexpr (Epi::AFTER_DRAIN) { E.fused(acc, cur, wr, wc, fr, fq, lds, wid, lane); S.done(cur); }
#undef PG8_SA
#undef PG8_AOFF
#undef PG8_SB
#undef PG8_STAGE
#undef PG8_LDA
#undef PG8_LDB
#undef PG8_MMA
#undef PG8_WAIT_V
#undef PG8_WAIT_L
#undef PG8_BAR
#undef PG8_SCHED
}
}

#include <hip/hip_bf16.h>
#include <cmath>
namespace attn_body {
using bf16=__hip_bfloat16;
using bf16x8=__attribute__((ext_vector_type(8)))short;
using s16x4=__attribute__((ext_vector_type(4)))short;
using f32x16=__attribute__((ext_vector_type(16)))float;
using u32x4=__attribute__((ext_vector_type(4)))unsigned;
using f32x4v=__attribute__((ext_vector_type(4)))float;
constexpr int BATCH=4,NHEAD=16,SEQ=8192,D=64,DM=NHEAD*D;
constexpr int NW=8,QBLK=32,QB=QBLK*NW,KVBLK=64,NQB=SEQ/QB;
constexpr int ATTN_PITCH=DM, ATTN_UNIT_ROWS=QB;
__device__ __forceinline__ int crow(int r,int hi){return (r&3)+8*(r>>2)+4*hi;}
#define SBAR() __builtin_amdgcn_sched_barrier(0)
__device__ __forceinline__ void cmask(f32x16&p0,f32x16&p1,int jb,int qrel,int hi){
  const float NEG=-INFINITY; int kb=64*jb+4*hi;
  #pragma unroll
  for(int r=0;r<16;++r){int kv=kb+(r&3)+8*(r>>2); if(kv>qrel)p0[r]=NEG; if(kv+32>qrel)p1[r]=NEG;}
}

constexpr int NSLOT=3, SLOTB=8192;
constexpr int LDS_K=0, LDS_V=NSLOT*SLOTB, LDS_WS=2*NSLOT*SLOTB, LDS_OST=LDS_WS+NW*64*4, LDS_F=86016, LDS_BYTES=LDS_F+SEQ*4;
constexpr float C2=0.125f*1.4426950408889634f;
__device__ __forceinline__ void glds16(const void*gsrc,unsigned lds_dst){unsigned keep;
  asm volatile("s_mov_b32 %0, m0\n\ts_mov_b32 m0, %2\n\ts_nop 0\n\tglobal_load_lds_dwordx4 %1, off\n\ts_mov_b32 m0, %0":"=&s"(keep):"v"(gsrc),"s"(lds_dst):"memory");}
__device__ __forceinline__ float max3f(float a,float b,float c){float r;asm("v_max3_f32 %0, %1, %2, %3":"=v"(r):"v"(a),"v"(b),"v"(c));return r;}
__device__ __forceinline__ float max2f(float a,float b){float r;asm("v_max_f32_e32 %0, %1, %2":"=v"(r):"v"(a),"v"(b));return r;}
__device__ __forceinline__ float fadd_s(float a,float b){float r;asm("v_add_f32_e32 %0, %1, %2":"=v"(r):"v"(a),"v"(b));return r;}
__device__ __forceinline__ float fsub_s(float a,float b){float r;asm("v_sub_f32_e32 %0, %1, %2":"=v"(r):"v"(a),"v"(b));return r;}
typedef float f32x2_t __attribute__((ext_vector_type(2))); typedef __bf16 bf16x2_t __attribute__((ext_vector_type(2)));
__device__ __forceinline__ unsigned cvtpk_s(float lo,float hi){f32x2_t v={lo,hi};bf16x2_t b=__builtin_convertvector(v,bf16x2_t);return __builtin_bit_cast(unsigned,b);}
#define WAIT_BAR(N) asm volatile("s_waitcnt vmcnt(" #N ") lgkmcnt(0)\n\ts_barrier":::"memory")

__device__ __forceinline__ void qkt(f32x16&p0,f32x16&p1,const char*Kslot,const bf16x8*qr,int r32,int hi){
  const char*kb=Kslot+hi*1024+r32*16;
  #pragma unroll
  for(int d0=0;d0<4;++d0){
    const bf16x8 b0=*reinterpret_cast<const bf16x8*>(kb+d0*2048);
    const bf16x8 b1=*reinterpret_cast<const bf16x8*>(kb+d0*2048+512);
    {p0=__builtin_amdgcn_mfma_f32_32x32x16_bf16(b0,qr[d0],p0,0,0,0);p1=__builtin_amdgcn_mfma_f32_32x32x16_bf16(b1,qr[d0],p1,0,0,0);}}
}
typedef __attribute__((address_space(3))) const char* lds_cptr;
typedef short v4i16_t __attribute__((ext_vector_type(4)));
__device__ __forceinline__ void kload8(bf16x8*kf,lds_cptr kp){
  kf[0]=*(const __attribute__((address_space(3))) bf16x8*)(kp);      kf[1]=*(const __attribute__((address_space(3))) bf16x8*)(kp+512);
  kf[2]=*(const __attribute__((address_space(3))) bf16x8*)(kp+2048); kf[3]=*(const __attribute__((address_space(3))) bf16x8*)(kp+2560);
  kf[4]=*(const __attribute__((address_space(3))) bf16x8*)(kp+4096); kf[5]=*(const __attribute__((address_space(3))) bf16x8*)(kp+4608);
  kf[6]=*(const __attribute__((address_space(3))) bf16x8*)(kp+6144); kf[7]=*(const __attribute__((address_space(3))) bf16x8*)(kp+6656);
}
__device__ __forceinline__ void kload2(bf16x8*kf,lds_cptr kp,int j){ kf[2*j]=*(const __attribute__((address_space(3))) bf16x8*)(kp+j*2048); kf[2*j+1]=*(const __attribute__((address_space(3))) bf16x8*)(kp+j*2048+512); }
__device__ __forceinline__ s16x4 vtr(lds_cptr p){ return __builtin_bit_cast(s16x4,__builtin_amdgcn_ds_read_tr16_b64_v4i16((__attribute__((address_space(3))) v4i16_t*)p)); }
__device__ __forceinline__ float rowmax(const f32x16&p0,const f32x16&p1){
  float a=max3f(p0[0],p0[1],p1[0]),b=max3f(p0[2],p0[3],p1[1]);a=max3f(a,p1[2],p1[3]);
  #pragma unroll
  for(int r=4;r<16;r+=4){a=max3f(a,p0[r],p0[r+1]);b=max3f(b,p0[r+2],p0[r+3]);a=max3f(a,p1[r],p1[r+1]);b=max3f(b,p1[r+2],p1[r+3]);}
  const float m=max2f(a,b);
  auto rr=__builtin_amdgcn_permlane32_swap(__float_as_uint(m),__float_as_uint(m),false,false);
  return max2f(__uint_as_float(rr[0]),__uint_as_float(rr[1]));
}
__device__ __forceinline__ void pv(f32x16*o,int vb,bf16x8 pa0,bf16x8 pa1,bf16x8 pa2,bf16x8 pa3){
  #pragma unroll
  for(int d0=0;d0<2;++d0){s16x4 lo[4],hi[4];
    #pragma unroll
    for(int ks=0;ks<4;++ks){
      asm volatile("ds_read_b64_tr_b16 %0,%1 offset:%c2":"=&v"(lo[ks]):"v"(vb),"i"(d0*4096+ks*1024):"memory");
      asm volatile("ds_read_b64_tr_b16 %0,%1 offset:%c2":"=&v"(hi[ks]):"v"(vb),"i"(d0*4096+ks*1024+512):"memory");}
    asm volatile("s_waitcnt lgkmcnt(0)":::"memory");SBAR();
    #define PK(k) (bf16x8){lo[k][0],lo[k][1],lo[k][2],lo[k][3],hi[k][0],hi[k][1],hi[k][2],hi[k][3]}
    o[d0]=__builtin_amdgcn_mfma_f32_32x32x16_bf16(pa0,PK(0),o[d0],0,0,0);
    o[d0]=__builtin_amdgcn_mfma_f32_32x32x16_bf16(pa1,PK(1),o[d0],0,0,0);
    o[d0]=__builtin_amdgcn_mfma_f32_32x32x16_bf16(pa2,PK(2),o[d0],0,0,0);
    o[d0]=__builtin_amdgcn_mfma_f32_32x32x16_bf16(pa3,PK(3),o[d0],0,0,0);
    #undef PK
  }
}

#ifndef ATTN_STORE16
#define ATTN_STORE16(p,v) (*(u32x4*)(p)=(v))
#endif
template<int THRL> __device__ __forceinline__ void attn_unit(int b,int h,int qb,int t0,const bf16*Q,const bf16*__restrict__ K,const bf16*__restrict__ V,bf16*O,const bf16*__restrict__ Gt,const float*__restrict__ Fg,char*shm){
  const int tid=threadIdx.x,lane=tid&63,r32=lane&31,hi=lane>>5; const int wid=__builtin_amdgcn_readfirstlane(tid>>6);
  const long rowbase=(long)b*SEQ; const int q0=qb*QB;
  const bf16*Qw=Q+(rowbase+q0+wid*QBLK)*DM+h*D;
  const bf16*Kh=K+(rowbase+(long)t0*KVBLK)*DM+h*D,*Vh=V+(rowbase+(long)t0*KVBLK)*DM+h*D;
  const unsigned lds0=(unsigned)(uintptr_t)shm;
  float*wsf=(float*)(shm+LDS_WS)+wid*64;
  const bf16*ksrc=Kh+(long)lane*DM+wid*8;
  const bf16*vsrc=Vh+(long)(16*(wid&3)+(lane>>2))*DM+(wid>>2)*32+(lane&3)*8;
  const unsigned kdst=lds0+LDS_K+wid*1024, vdst=lds0+LDS_V+wid*1024;
  #define DMA_K(t,slot) glds16(ksrc+(long)(t)*KVBLK*DM,(unsigned)__builtin_amdgcn_readfirstlane(kdst+(slot)))
  #define DMA_V(t,slot) glds16(vsrc+(long)(t)*KVBLK*DM,(unsigned)__builtin_amdgcn_readfirstlane(vdst+(slot)))
  const int vb0=(int)(lds0+LDS_V)+((lane>>4)&1)*32+(lane&3)*8+(4*hi+((lane&15)>>2))*64;
  const char*Kbase=shm+LDS_K; bf16x8 kf[8];
  const lds_cptr shm3=(lds_cptr)shm; const lds_cptr kp0=shm3+LDS_K+hi*1024+r32*16; const lds_cptr vp0=shm3+LDS_V+((lane>>4)&1)*32+(lane&3)*8+(4*hi+((lane&15)>>2))*64;
  const int NT=(q0+QB)/KVBLK-t0;
  typedef __attribute__((address_space(3))) float* lds_fptr; typedef __attribute__((address_space(3))) const f32x4v* lds_f4c;
  const float*Fsrc=Fg+((long)b*NHEAD+h)*SEQ; const lds_fptr Fl=(lds_fptr)(shm+LDS_F);
  const float fqv=Fsrc[q0+wid*QBLK+r32]; float fqm=fqv;
  #define FLD(X0,X1,tt) do{ const lds_fptr fp_=Fl+64*(tt)+4*hi; _Pragma("unroll") for(int a_=0;a_<4;++a_){ const f32x4v u0_=*(lds_f4c)(fp_+8*a_), u1_=*(lds_f4c)(fp_+32+8*a_); \
      X0[4*a_]=u0_[0];X0[4*a_+1]=u0_[1];X0[4*a_+2]=u0_[2];X0[4*a_+3]=u0_[3]; X1[4*a_]=u1_[0];X1[4*a_+1]=u1_[1];X1[4*a_+2]=u1_[2];X1[4*a_+3]=u1_[3]; } }while(0)
  typedef float f32x2p __attribute__((ext_vector_type(2)));
  #define SUBF(X0,X1) do{ const f32x2p fq2_={fqm,fqm}; _Pragma("unroll") for(int r=0;r<16;r+=2){ f32x2p a_={X0[r],X0[r+1]}, b_={X1[r],X1[r+1]}; a_=fq2_-a_; b_=fq2_-b_; X0[r]=a_[0];X0[r+1]=a_[1];X1[r]=b_[0];X1[r+1]=b_[1]; } asm volatile("":"+v"(X0),"+v"(X1)); }while(0)
  DMA_K(0,0);DMA_V(0,0);DMA_K(1,SLOTB);
  bf16x8 qr[4];
  #pragma unroll
  for(int d0=0;d0<4;++d0)qr[d0]=*reinterpret_cast<const bf16x8*>(&Qw[(long)r32*DM+d0*16+hi*8]);
  float mhat=0.f,l_reg=0.f;f32x16 o[2];o[0]=f32x16{};o[1]=f32x16{};
  const int qrel=wid*QBLK+r32;
  #define CMASK(P0,P1,t) do{int jb_=(t)-(NT-4); if(jb_>=0)cmask(P0,P1,jb_,qrel,hi);}while(0)
  bool resc=false;
  #define START(P0,P1) do{ const float rm=rowmax(P0,P1); resc=false; \
    { const float dl=max2f(rm,0.f); mhat=fadd_s(mhat,dl); \
      _Pragma("unroll") for(int r=0;r<16;++r){P0[r]=fsub_s(P0[r],dl);P1[r]=fsub_s(P1[r],dl);} \
      fqm=fqv-mhat; } \
    _Pragma("unroll") for(int r=0;r<16;++r)P0[r]=__builtin_amdgcn_exp2f(P0[r]); }while(0)
  #define RESC() do{ if(resc){ asm volatile("s_waitcnt lgkmcnt(0)":::"memory"); \
      _Pragma("unroll") for(int d_=0;d_<2;++d_) _Pragma("unroll") for(int r=0;r<16;++r)o[d_][r]*=wsf[crow(r,hi)]; } }while(0)
  f32x16 pA0,pA1,pB0,pB1;
  int sl_prev=0,sl_cur=0,sl_next=SLOTB;
  #define ROT() do{sl_prev=sl_cur;sl_cur=sl_next;sl_next=(sl_next==(NSLOT-1)*SLOTB)?0:sl_next+SLOTB;}while(0)
  DMA_K(2,2*SLOTB);
  { const float*Fs0=Fsrc+t0*KVBLK; const int n4=NT*(KVBLK/4); for(int i=tid;i<n4;i+=NW*64){ const f32x4v v=*(const f32x4v*)(Fs0+4*i); *(__attribute__((address_space(3))) f32x4v*)(Fl+4*i)=v; } }
  WAIT_BAR(3);
  FLD(pA0,pA1,0); SUBF(pA0,pA1); qkt(pA0,pA1,Kbase,qr,r32,hi);asm volatile("s_nop 15\n\ts_nop 7":"+v"(pA0),"+v"(pA1));CMASK(pA0,pA1,0);
  START(pA0,pA1);
  _Pragma("unroll") for(int r=0;r<16;++r)pA1[r]=__builtin_amdgcn_exp2f(pA1[r]);
  WAIT_BAR(0);
  DMA_K(3,0);DMA_V(1,SLOTB);
  ROT();
  kload8(kf,kp0+sl_cur);
  FLD(pB0,pB1,1);
  WAIT_BAR(2);
  s16x4 vlo[8],vhi[8]; u32x4 pw0,pw1,pw2,pw3;
  #define PKW(P,B) cvtpk_s(P[B],P[B+1])
  #define PAF(k) __builtin_bit_cast(bf16x8,pw##k)
  #define VFR(i) (bf16x8){vlo[i][0],vlo[i][1],vlo[i][2],vlo[i][3],vhi[i][0],vhi[i][1],vhi[i][2],vhi[i][3]}
  #define PIN(x) asm volatile("":"+v"(x))
  #define MX3(a,b,c) __builtin_fmaxf(__builtin_fmaxf((a),(b)),(c))
  #define GAPA(CD,MF,A0,A1,A2,A3,W0,W1,PW) do{ MF; PIN(CD); sacc+=A0; sacc+=A1; sacc+=A2; sacc+=A3; PIN(sacc); W0; W1; PIN(PW); SBAR(); }while(0)
  #define EX(v) __builtin_amdgcn_exp2f(v)
  #define GAPB(MF,X,B) do{ MF; X[B]=EX(X[B]); X[B+1]=EX(X[B+1]); X[B+2]=EX(X[B+2]); X[B+3]=EX(X[B+3]); PIN(X); SBAR(); }while(0)
  #define VRD(i) do{ vlo[i]=vtr(vp_+(((i)>>2)*4096+((i)&3)*1024)); vhi[i]=vtr(vp_+(((i)>>2)*4096+((i)&3)*1024+512)); }while(0)
  #define KRD(G,j) do{ if(G){ kload2(kf,kp0+sl_next,j); SBAR(); } }while(0)
  #define STEP(C0,C1,P0,P1,t,GK,GV,GL) do{ SBAR(); SUBF(C0,C1); SBAR(); \
    const lds_cptr vp_=vp0+sl_prev; \
    VRD(0); SBAR(); float sacc=(P0[0]+P0[1]); \
    GAPA(C0,C0=__builtin_amdgcn_mfma_f32_32x32x16_bf16(kf[0],qr[0],C0,0,0,0), P0[2],P0[3],P0[4],P0[5],     pw0[0]=PKW(P0,0), pw0[1]=PKW(P0,2), pw0); \
    VRD(4); SBAR(); GAPA(C1,C1=__builtin_amdgcn_mfma_f32_32x32x16_bf16(kf[1],qr[0],C1,0,0,0), P0[6],P0[7],P0[8],P0[9],     pw0[2]=PKW(P0,4), pw0[3]=PKW(P0,6), pw0); \
    VRD(1); SBAR(); GAPA(C0,C0=__builtin_amdgcn_mfma_f32_32x32x16_bf16(kf[2],qr[1],C0,0,0,0),   P0[10],P0[11],P0[12],P0[13], pw1[0]=PKW(P0,8), pw1[1]=PKW(P0,10), pw1); \
    VRD(5); SBAR(); GAPA(C1,C1=__builtin_amdgcn_mfma_f32_32x32x16_bf16(kf[3],qr[1],C1,0,0,0),   P0[14],P0[15],P1[0],P1[1],   pw1[2]=PKW(P0,12),pw1[3]=PKW(P0,14), pw1); \
    VRD(2); SBAR(); GAPA(C0,C0=__builtin_amdgcn_mfma_f32_32x32x16_bf16(kf[4],qr[2],C0,0,0,0),   P1[2],P1[3],P1[4],P1[5],     pw2[0]=PKW(P1,0), pw2[1]=PKW(P1,2), pw2); \
    VRD(6); SBAR(); GAPA(C1,C1=__builtin_amdgcn_mfma_f32_32x32x16_bf16(kf[5],qr[2],C1,0,0,0),   P1[6],P1[7],P1[8],P1[9],     pw2[2]=PKW(P1,4), pw2[3]=PKW(P1,6), pw2); \
    VRD(3); SBAR(); GAPA(C0,C0=__builtin_amdgcn_mfma_f32_32x32x16_bf16(kf[6],qr[3],C0,0,0,0),   P1[10],P1[11],P1[12],P1[13], pw3[0]=PKW(P1,8), pw3[1]=PKW(P1,10), pw3); \
    VRD(7); SBAR(); GAPA(C1,C1=__builtin_amdgcn_mfma_f32_32x32x16_bf16(kf[7],qr[3],C1,0,0,0),   P1[14],P1[15],0.f,0.f,       pw3[2]=PKW(P1,12),pw3[3]=PKW(P1,14), pw3); \
    l_reg+=sacc; if(GL){ FLD(P0,P1,(t)+1); } \
    if(GK){DMA_K((t)+3,sl_cur);} if(GV){DMA_V((t)+1,sl_next);} \
    CMASK(C0,C1,t); \
    { float a=MX3(C0[0],C0[1],C1[0]),b=MX3(C0[2],C0[3],C1[1]); a=MX3(a,C1[2],C1[3]); \
      _Pragma("unroll") for(int r=4;r<16;r+=4){a=MX3(a,C0[r],C0[r+1]);b=MX3(b,C0[r+2],C0[r+3]);a=MX3(a,C1[r],C1[r+1]);b=MX3(b,C1[r+2],C1[r+3]);} \
      float rm=__builtin_fmaxf(a,b); { auto rr=__builtin_amdgcn_permlane32_swap(__float_as_uint(rm),__float_as_uint(rm),false,false); rm=__builtin_fmaxf(__uint_as_float(rr[0]),__uint_as_float(rr[1])); } \
      resc=false; \
      if(__builtin_expect(__any(rm>(float)THRL),0)){ const float dl=__builtin_fmaxf(rm,0.f); mhat+=dl; \
        _Pragma("unroll") for(int r=0;r<16;++r){C0[r]-=dl;C1[r]-=dl;} \
        fqm=fqv-mhat; \
        const float f=__builtin_amdgcn_exp2f(-dl); l_reg*=f; if(hi==0)wsf[r32]=f; resc=true; } } \
    SBAR(); \
    GAPB(o[0]=__builtin_amdgcn_mfma_f32_32x32x16_bf16(PAF(0),VFR(0),o[0],0,0,0), C0,0); \
    GAPB(o[1]=__builtin_amdgcn_mfma_f32_32x32x16_bf16(PAF(0),VFR(4),o[1],0,0,0), C0,4); \
    KRD(GL,0); GAPB(o[0]=__builtin_amdgcn_mfma_f32_32x32x16_bf16(PAF(1),VFR(1),o[0],0,0,0), C0,8); \
    KRD(GL,1); GAPB(o[1]=__builtin_amdgcn_mfma_f32_32x32x16_bf16(PAF(1),VFR(5),o[1],0,0,0), C0,12); \
    KRD(GL,2); GAPB(o[0]=__builtin_amdgcn_mfma_f32_32x32x16_bf16(PAF(2),VFR(2),o[0],0,0,0), C1,0); \
    KRD(GL,3); GAPB(o[1]=__builtin_amdgcn_mfma_f32_32x32x16_bf16(PAF(2),VFR(6),o[1],0,0,0), C1,4); \
    GAPB(o[0]=__builtin_amdgcn_mfma_f32_32x32x16_bf16(PAF(3),VFR(3),o[0],0,0,0), C1,8); \
    GAPB(o[1]=__builtin_amdgcn_mfma_f32_32x32x16_bf16(PAF(3),VFR(7),o[1],0,0,0), C1,12); \
    }while(0)
  int t=1;
  #undef CMASK
  #define CMASK(P0,P1,t) do{}while(0)
  for(;t+5<NT;t+=2){
    STEP(pB0,pB1,pA0,pA1,t,true,true,true);     WAIT_BAR(2); RESC(); ROT();
    STEP(pA0,pA1,pB0,pB1,t+1,true,true,true);   WAIT_BAR(2); RESC(); ROT();
  }
  #undef CMASK
  #define CMASK(P0,P1,t) do{int jb_=(t)-(NT-4); if(jb_>=0)cmask(P0,P1,jb_,qrel,hi);}while(0)
  #define ENDW(tt) do{ if((tt)+3<NT){WAIT_BAR(2);} else if((tt)+2<NT){WAIT_BAR(1);} else {WAIT_BAR(0);} }while(0)
  for(;t+1<NT;t+=2){
    STEP(pB0,pB1,pA0,pA1,t,(t+3<NT),(t+1<NT),(t+1<NT));       ENDW(t);   RESC(); ROT();
    STEP(pA0,pA1,pB0,pB1,t+1,(t+4<NT),(t+2<NT),(t+2<NT));     ENDW(t+1); RESC(); ROT();
  }
  STEP(pB0,pB1,pA0,pA1,NT-1,false,false,false); RESC();
  { float sacc=pB0[0]+pB0[1]; _Pragma("unroll") for(int r=2;r<16;++r)sacc+=pB0[r]; _Pragma("unroll") for(int r=0;r<16;++r)sacc+=pB1[r]; l_reg+=sacc;
    pw0=(u32x4){PKW(pB0,0),PKW(pB0,2),PKW(pB0,4),PKW(pB0,6)};pw1=(u32x4){PKW(pB0,8),PKW(pB0,10),PKW(pB0,12),PKW(pB0,14)};pw2=(u32x4){PKW(pB1,0),PKW(pB1,2),PKW(pB1,4),PKW(pB1,6)};pw3=(u32x4){PKW(pB1,8),PKW(pB1,10),PKW(pB1,12),PKW(pB1,14)};
    SBAR(); pv(o,vb0+sl_cur,PAF(0),PAF(1),PAF(2),PAF(3)); }
  #undef PKW
  #undef PAF
  #undef VFR
  #undef PIN
  #undef MX3
  #undef GAPA
  #undef GAPB
  #undef EX
  #undef VRD
  #undef KRD
  #undef STEP
  #undef ENDW
  {auto rr=__builtin_amdgcn_permlane32_swap(__float_as_uint(l_reg),__float_as_uint(l_reg),false,false);l_reg=__uint_as_float(rr[0])+__uint_as_float(rr[1]);}
  if(hi==0)wsf[32+r32]=l_reg;asm volatile("s_waitcnt lgkmcnt(0)":::"memory");
  float rli[16];
  #pragma unroll
  for(int r=0;r<16;++r)rli[r]=__builtin_amdgcn_rcpf(wsf[32+crow(r,hi)]);
  bf16*Ow=O+(rowbase+q0+wid*QBLK)*DM+h*D; const bf16*Gw=Gt+(rowbase+q0+wid*QBLK)*DM+h*D;
  { bf16*stg=(bf16*)(shm+LDS_OST)+wid*2048;
    #pragma unroll
    for(int r=0;r<16;++r){const int orow=crow(r,hi);
      #pragma unroll
      for(int d0=0;d0<2;++d0)stg[orow*64+d0*32+r32]=__float2bfloat16(o[d0][r]*rli[r]);}
    asm volatile("s_waitcnt lgkmcnt(0)":::"memory");
    #pragma unroll
    for(int i=0;i<4;++i){const int row=i*8+(lane>>3),ch=lane&7; u32x4 v=*(const u32x4*)(stg+row*64+ch*8); const u32x4 gv=*(const u32x4*)(Gw+(long)row*DM+ch*8);
      _Pragma("unroll") for(int e=0;e<4;++e){ const float a0=__uint_as_float(v[e]<<16),a1=__uint_as_float(v[e]&0xffff0000u),g0=__uint_as_float(gv[e]<<16),g1=__uint_as_float(gv[e]&0xffff0000u); v[e]=cvtpk_s(a0*g0,a1*g1); }
      ATTN_STORE16(Ow+(long)row*DM+ch*8,v);} }
  asm volatile("s_waitcnt lgkmcnt(0)\n\ts_barrier":::"memory");
  #undef DMA_K
  #undef FLD
  #undef SUBF
  #undef DMA_V
  #undef CMASK
  #undef START
  #undef RESC
  #undef ROT
}
constexpr int ATTN_LDS_BYTES=LDS_BYTES;
constexpr long K_OFF=-67108864L, V_OFF=-33554432L, G_OFF=33554432L, O_OFF=-101711872L;
struct AttnTensors { bf16* Q; const float* F; const int* T0; };
struct AttnUnit { int bh; int qb; int t0; };
struct StaticOrder {
  const int* lst; int n;
  __device__ __forceinline__ explicit StaticOrder(const int* l,int cnt):lst(l),n(cnt){}
  __device__ __forceinline__ bool next(int i,AttnUnit&u)const{ if(i>=n)return false; const int w=__builtin_amdgcn_readfirstlane(lst[i]); const int un=w&0xffff; u.bh=un>>5; u.qb=un&31; u.t0=w>>16; return true; }
  __device__ __forceinline__ void a_ready(const AttnUnit&)const{}
  __device__ __forceinline__ void done(const AttnUnit&)const{}
};
template<class Sched,int THRL=8> __device__ __forceinline__ void attn_phase(char*lds,const AttnTensors&T,const Sched&S){
  AttnUnit u;
  for(int i=0;S.next(i,u);++i){ S.a_ready(u); attn_unit<THRL>(u.bh/NHEAD,u.bh%NHEAD,u.qb,u.t0,T.Q,T.Q+K_OFF,T.Q+V_OFF,T.Q+O_OFF,T.Q+G_OFF,T.F,lds); S.done(u); }
}
#undef SBAR
#undef WAIT_BAR
}

namespace cg = cooperative_groups;
constexpr int NWAVES = 8;
constexpr int BATCH = 4, SEQ = 8192, D = 1024, M = BATCH * SEQ, DFF = 2816, SGW = 2048;
constexpr float EPS = 1e-6f;
constexpr int NSYNC = 1;
constexpr unsigned long long REPMASK = 0ull;
constexpr size_t MiB = 1u << 20;
constexpr size_t WS_MODP = 1 * MiB, WS_MOD = 4 * MiB, WS_T0 = 4 * MiB + 512 * 1024, WS_WSM = 5 * MiB;
constexpr size_t WS_WFI = 6 * MiB, WS_WFO = 15 * MiB, WS_WSI = 17 * MiB, WS_WSO = 25 * MiB, WS_WUP0 = 29 * MiB, WS_WUP1 = 40 * MiB, WS_WDN0 = 51 * MiB, WS_WDN1 = 57 * MiB;
constexpr size_t WS_HN = 66 * MiB, WS_X1 = 132 * MiB, WS_K = 132 * MiB, WS_V = 196 * MiB, WS_VS = 132 * MiB;
constexpr size_t WS_Q = 260 * MiB, WS_G = 324 * MiB, WS_ACT = 260 * MiB, WS_U = 260 * MiB;
constexpr size_t WS_LOGF = 436 * MiB, WS_F = 438 * MiB, WS_STATS = 440 * MiB, WS_END = 448 * MiB;
constexpr int RING_BYTES = 131072, LDS_BYTES = 147456, LDSCTL_OFF = 143360;
constexpr size_t WS_CTL = 0, CTL_ZERO_BYTES = 65536;
static_assert(attn_body::ATTN_LDS_BYTES <= RING_BYTES, "attention LDS");

#define GAS __attribute__((address_space(1)))
#define LAS __attribute__((address_space(3)))
typedef unsigned short bf16;
typedef unsigned v4u __attribute__((ext_vector_type(4)));
typedef unsigned v2u __attribute__((ext_vector_type(2)));
typedef float f32x4 __attribute__((ext_vector_type(4)));
typedef float f32x2 __attribute__((ext_vector_type(2)));
typedef short bf16x8 __attribute__((ext_vector_type(8)));
#define LDS_WAIT() asm volatile("s_waitcnt lgkmcnt(0)" ::: "memory")
__device__ __forceinline__ unsigned f2bf(float f) { unsigned u = __builtin_bit_cast(unsigned, f); return (u + 0x7fffu + ((u >> 16) & 1u)) >> 16; }
__device__ __forceinline__ unsigned pk2(float lo, float hi) { return f2bf(lo) | (f2bf(hi) << 16); }
__device__ __forceinline__ float bflo(unsigned w) { return __uint_as_float(w << 16); }
__device__ __forceinline__ float bfhi(unsigned w) { return __uint_as_float(w & 0xffff0000u); }
__device__ __forceinline__ float wave_sum(float v) {
#pragma unroll
    for (int o = 1; o < 64; o <<= 1) v += __shfl_xor(v, o);
    return v;
}
template <int MODE> __device__ __forceinline__ int phys_blk(int nb) {
    if (MODE == 1) { if (nb >= 128) return nb; const int pn = nb >> 3, r = nb & 7; return pn * 8 + (r & 1) * 4 + (r >> 1); }
    if (MODE == 2) { const int bj = nb / 88, q = nb % 88; return (q >> 2) * 8 + bj * 4 + (q & 3); }
    return nb;
}
template <int MODE> __device__ __forceinline__ void transpose_item(const float* W, int K, int N, bf16* WT, LAS float* scr, int item, int lane) {
    const int nblk = (N + 63) / 64, kb = item / nblk, nb = item % nblk, k0 = 64 * kb, n0 = 64 * nb; const int kr = lane >> 4, nc = 4 * (lane & 15); const bool ok = n0 + nc < N;
#pragma unroll 8
    for (int i = 0; i < 16; ++i) { const int kk = 4 * i + kr; f32x4 v = (f32x4){0.f, 0.f, 0.f, 0.f}; if (ok) v = *(const f32x4*)(W + (size_t)(k0 + kk) * N + n0 + nc);
        LAS float* d = scr + kk * 65 + nc; d[0] = v.x; d[1] = v.y; d[2] = v.z; d[3] = v.w; }
    LDS_WAIT(); asm volatile("" ::: "memory");
    const int c = lane & 7;
#pragma unroll
    for (int j = 0; j < 8; ++j) { const int n = (lane >> 3) + 8 * j; const int pb = phys_blk<MODE>(2 * nb + (n >> 5)); const LAS float* s = scr + (8 * c) * 65 + n;
        v4u o; o.x = pk2(s[0 * 65], s[1 * 65]); o.y = pk2(s[2 * 65], s[3 * 65]); o.z = pk2(s[4 * 65], s[5 * 65]); o.w = pk2(s[6 * 65], s[7 * 65]);
        *(GAS v4u*)(WT + (size_t)(pb * 32 + (n & 31)) * K + k0 + 8 * c) = o; }
    LDS_WAIT(); asm volatile("" ::: "memory");
}
__device__ __forceinline__ void norm_row_bf16(const unsigned short* xrow, const float* g, const float* sh, const float* sc, bf16* orow, int lane) {
    const v4u a = *(const GAS v4u*)(xrow + 8 * lane), b = *(const GAS v4u*)(xrow + 512 + 8 * lane); float v[16]; float s = 0.f;
#pragma unroll
    for (int i = 0; i < 4; ++i) { v[2 * i] = pg8::h_lo(a[i]); v[2 * i + 1] = pg8::h_hi(a[i]); v[8 + 2 * i] = pg8::h_lo(b[i]); v[8 + 2 * i + 1] = pg8::h_hi(b[i]); }
#pragma unroll
    for (int i = 0; i < 16; ++i) s += v[i] * v[i];
    const float rstd = 1.0f / sqrtf(wave_sum(s) * (1.f / D) + EPS);
#pragma unroll
    for (int h = 0; h < 2; ++h) { const int c = 512 * h + 8 * lane; v4u w;
#pragma unroll
        for (int q = 0; q < 2; ++q) { const f32x4 gg = *(const f32x4*)(g + c + 4 * q), s1 = *(const f32x4*)(sc + c + 4 * q), s0 = *(const f32x4*)(sh + c + 4 * q);
            const f32x4 x4 = {v[8 * h + 4 * q], v[8 * h + 4 * q + 1], v[8 * h + 4 * q + 2], v[8 * h + 4 * q + 3]}; const f32x4 y = x4 * rstd * gg * (s1 + 1.0f) + s0;
            w[2 * q] = pk2(y.x, y.y); w[2 * q + 1] = pk2(y.z, y.w); }
        *(GAS v4u*)(orow + c) = w; }
}
#define XB_TMO      128
#define XB_XCNT(j)  (256  + 64 * (j))
#define XB_XSUB(j)  (1280 + 64 * (j))
#define XB_XGEN(j)  (2304 + 64 * (j))
#define XB_TOP      3328
#define XB_TOPGEN   3392
#define XCD_BAR_WORDS 3456
#define XB_SPIN_CAP (1u << 18)

__device__ __forceinline__ unsigned xb_ld(unsigned* p)              { return __hip_atomic_load(p, __ATOMIC_RELAXED, __HIP_MEMORY_SCOPE_AGENT); }
__device__ __forceinline__ unsigned xb_add(unsigned* p, unsigned v) { return __hip_atomic_fetch_add(p, v, __ATOMIC_RELAXED, __HIP_MEMORY_SCOPE_AGENT); }
__device__ __forceinline__ unsigned xb_xcc_id() { return (unsigned)__builtin_amdgcn_s_getreg((3 << 11) | 20) & 0xFu; }
#define XB_SPIN(cond, bar) do { unsigned _sp = 0; while (cond) { __builtin_amdgcn_s_sleep(1); \
    if ((++_sp & 255u) == 0u) { if (xb_ld(&(bar)[XB_TMO])) break; if (_sp > XB_SPIN_CAP) { atomicAdd(&(bar)[XB_TMO], 1u); break; } } } } while (0)

struct XcdBarrier {
    unsigned* bar; unsigned x;
    volatile LAS unsigned* st;
};

__device__ __forceinline__ XcdBarrier xcd_barrier_post(unsigned* bar, volatile LAS unsigned* st) {
    XcdBarrier b; b.bar = bar; b.x = xb_xcc_id(); b.st = st;
    if (threadIdx.x == 0) (void)xb_add(&bar[XB_XCNT(b.x)], 1u);
    return b;
}
__device__ __forceinline__ void xcd_barrier_complete(unsigned* bar, unsigned x, unsigned& nloc, unsigned& nx) {
    const unsigned G = gridDim.x * gridDim.y * gridDim.z;
    unsigned sum, cnt, mine, sp = 0u;
    for (;;) {
        sum = 0u; cnt = 0u; mine = 0u;
#pragma unroll
        for (unsigned j = 0; j < 16; ++j) { const unsigned c = xb_ld(&bar[XB_XCNT(j)]); sum += c; cnt += (c > 0u) ? 1u : 0u; mine = (j == x) ? c : mine; }
        if (sum == G) break;
        __builtin_amdgcn_s_sleep(1);
        if ((++sp & 255u) == 0u) { if (xb_ld(&bar[XB_TMO])) break; if (sp > XB_SPIN_CAP) { atomicAdd(&bar[XB_TMO], 1u); break; } }
    }
    nloc = mine > 0u ? mine : 1u; nx = cnt > 0u ? cnt : 1u;
}

__device__ __forceinline__ void xcd_barrier(const XcdBarrier& b) {
    asm volatile("s_waitcnt vmcnt(0)" ::: "memory");
    __syncthreads();
    if (threadIdx.x == 0) {
        unsigned* bar = b.bar;
        __builtin_amdgcn_s_waitcnt(0);
        unsigned nloc = b.st[0], nx = b.st[1];
        if (nloc == 0u) { xcd_barrier_complete(bar, b.x, nloc, nx); b.st[0] = nloc; b.st[1] = nx; }
        const unsigned old = xb_add(&bar[XB_XSUB(b.x)], 1u);
        const unsigned gen = old / nloc;
        if (old + 1u == (gen + 1u) * nloc) {
            __builtin_amdgcn_fence(__ATOMIC_RELEASE, "agent");
            asm volatile("s_waitcnt vmcnt(0)" ::: "memory");
            const unsigned og = xb_add(&bar[XB_TOP], 1u);
            const unsigned tg = og / nx;
            if (og + 1u == (tg + 1u) * nx) xb_add(&bar[XB_TOPGEN], 1u);
            else XB_SPIN(xb_ld(&bar[XB_TOPGEN]) == tg, bar);
            __builtin_amdgcn_fence(__ATOMIC_ACQUIRE, "agent");
            xb_add(&bar[XB_XGEN(b.x)], 1u);
            asm volatile("s_waitcnt vmcnt(0)" ::: "memory");
        } else {
            XB_SPIN(xb_ld(&bar[XB_XGEN(b.x)]) == gen, bar);
            __builtin_amdgcn_fence(__ATOMIC_ACQUIRE, "agent");
            asm volatile("s_waitcnt vmcnt(0)" ::: "memory");
        }
    }
    __syncthreads();
}

struct Args { const float* in[23]; float* out; unsigned char* ws; int ph_lo, ph_hi; };
typedef __attribute__((address_space(4))) const unsigned char* kptr_t;
__device__ __forceinline__ kptr_t kargs() { kptr_t p = (kptr_t)__builtin_amdgcn_kernarg_segment_ptr(); asm volatile("" : "+s"(p)); return p; }
#define ARGP(off, T) (*(T const __attribute__((address_space(4)))*)(kargs() + (off)))

__global__ void __launch_bounds__(NWAVES * 64, 2) fwd_mega(Args args) {
    extern __shared__ __attribute__((aligned(16))) unsigned char lds[];
    cg::grid_group grid = cg::this_grid();
    LAS unsigned char* const ldsl = (LAS unsigned char*)lds;
    const int tid = threadIdx.x, lane = tid & 63, wave = __builtin_amdgcn_readfirstlane(tid >> 6);
    const int G = gridDim.x; const int bx = blockIdx.x; const int vcu = (G % 8 == 0) ? (bx % 8) * (G / 8) + bx / 8 : bx;
    const int gw = vcu * NWAVES + wave, NGW = G * NWAVES;
#define A_IN(i) ARGP(8 * (i), const float*)
#define ws ARGP(192, unsigned char*)
#define x_in A_IN(0)
#define out ARGP(184, float*)
#define MODP ((float*)(ws + WS_MODP))
#define MOD ((float*)(ws + WS_MOD))
#define T0 ((int*)(ws + WS_T0))
#define WSM ((bf16*)(ws + WS_WSM))
#define WFI ((bf16*)(ws + WS_WFI))
#define WFO ((bf16*)(ws + WS_WFO))
#define WSI ((bf16*)(ws + WS_WSI))
#define WSO ((bf16*)(ws + WS_WSO))
#define HN ((bf16*)(ws + WS_HN))
#define X1H ((unsigned short*)(ws + WS_X1))
#define X2H2 ((unsigned short*)(ws + WS_X1 + 64 * MiB))
#define X2H ((unsigned short*)out)
#define QB ((bf16*)(ws + WS_Q))
#define KB ((bf16*)(ws + WS_K))
#define VB ((bf16*)(ws + WS_V))
#define GB ((bf16*)(ws + WS_G))
#define ACT ((bf16*)(ws + WS_ACT))
#define UB ((bf16*)(ws + WS_U))
#define VS ((bf16*)(ws + WS_VS))
#define LOGF ((float*)(ws + WS_LOGF))
#define FB ((float*)(ws + WS_F))
#define STATS ((float*)(ws + WS_STATS))
    const int lo = ARGP(200, int), hi = ARGP(204, int);
    for (int u = tid; u < 64; u += NWAVES * 64) ((LAS unsigned*)(ldsl + LDSCTL_OFF))[u] = 0u;
    __syncthreads();
    XcdBarrier bar = xcd_barrier_post((unsigned*)(ws + WS_CTL), (volatile LAS unsigned*)(ldsl + LDSCTL_OFF) + 8);
    if (lo > 4096) grid.sync();
#define PHASE_BEGIN(k) if ((k) >= lo && (k) < hi) for (int rep_ = 0; rep_ <= (int)((REPMASK >> (k)) & 1ull); ++rep_) {
#define PHASE_END(k) if ((k) + 1 < hi) { for (int s_ = 0; s_ < NSYNC; ++s_) xcd_barrier(bar); } }
#define MODV(l, k) (MOD + (size_t)(l) * 4 * 6144 + (k) * 1024)

    constexpr int CV_FI = 16 * 65, CV_FO = 16 * 16, CV_SI = 16 * 64, CV_SO = 32 * 16, CV_UP = 16 * 88, CV_DN = 44 * 16;
    constexpr int CV_G2 = CV_FI, CV_G3 = CV_G2 + CV_FO + CV_UP + CV_DN, CV_END = CV_G3 + CV_SI + CV_SO + CV_UP + CV_DN;
#define CONVERT_ITEM(R, SCR) do { int r_ = (R); \
        if (r_ < CV_FI) { transpose_item<1>(A_IN(2), D, 4112, WFI, SCR, r_, lane); break; } r_ -= CV_FI; \
        if (r_ < CV_FO) { transpose_item<0>(A_IN(6), D, D, WFO, SCR, r_, lane); break; } r_ -= CV_FO; \
        if (r_ < CV_UP) { transpose_item<2>(A_IN(14), D, 5632, (bf16*)(ws + WS_WUP0), SCR, r_, lane); break; } r_ -= CV_UP; \
        if (r_ < CV_DN) { transpose_item<0>(A_IN(17), DFF, D, (bf16*)(ws + WS_WDN0), SCR, r_, lane); break; } r_ -= CV_DN; \
        if (r_ < CV_SI) { transpose_item<0>(A_IN(7), D, 4096, WSI, SCR, r_, lane); break; } r_ -= CV_SI; \
        if (r_ < CV_SO) { transpose_item<0>(A_IN(13), SGW, D, WSO, SCR, r_, lane); break; } r_ -= CV_SO; \
        if (r_ < CV_UP) { transpose_item<2>(A_IN(14) + (size_t)D * 5632, D, 5632, (bf16*)(ws + WS_WUP1), SCR, r_, lane); break; } r_ -= CV_UP; \
        transpose_item<0>(A_IN(17) + (size_t)DFF * D, DFF, D, (bf16*)(ws + WS_WDN1), SCR, r_, lane); } while (0)
    PHASE_BEGIN(0)
    {
        LAS float* scr = (LAS float*)(ldsl + wave * 16640);
        constexpr int I_MOD = 768;
        for (int it = gw; it < I_MOD + CV_FI; it += NGW) {
            int r = it;
            if (r >= I_MOD) { CONVERT_ITEM(r - I_MOD, scr); continue; }
            if (r < I_MOD) {
                const int l = r / 384, q = r % 384, nc = q >> 4, ks = q & 15, n0 = nc * 256 + 4 * lane, k0 = ks * 64;
                float ca[4];
#pragma unroll
                for (int b = 0; b < 4; ++b) { const float cv = A_IN(1)[b * D + k0 + lane]; ca[b] = cv / (1.0f + __expf(-cv)); }
                f32x4 a[4] = {(f32x4){0, 0, 0, 0}, (f32x4){0, 0, 0, 0}, (f32x4){0, 0, 0, 0}, (f32x4){0, 0, 0, 0}};
                const float* wp = A_IN(18) + ((size_t)l * D + k0) * 6144 + n0;
#pragma unroll 16
                for (int kk = 0; kk < 64; ++kk) { const f32x4 wv = *(const f32x4*)(wp + (size_t)kk * 6144);
#pragma unroll
                    for (int b = 0; b < 4; ++b) { const float cb = __builtin_bit_cast(float, __builtin_amdgcn_readlane(__builtin_bit_cast(int, ca[b]), kk)); a[b] += wv * cb; } }
#pragma unroll
                for (int b = 0; b < 4; ++b) *(f32x4*)(MODP + ((size_t)(ks * 2 + l) * 4 + b) * 6144 + n0) = a[b];
                continue;
            }
        }
        { v4u z = {0u, 0u, 0u, 0u}; GAS v4u* p = (GAS v4u*)(WFI + (size_t)4128 * D); const int n16 = 224 * D * 2 / 16; for (int i = gw * 64 + lane; i < n16; i += NGW * 64) p[i] = z; }
        for (int i = gw * 64 + lane; i < 8 * 128 * 128 / 2; i += NGW * 64) { const int e = 2 * i, s = e & 127, t = (e >> 7) & 127; const f32x2 w = *(const f32x2*)(A_IN(11) + e);
            const bool keep = (s >> 6) <= (t >> 6); ((GAS unsigned*)WSM)[i] = keep ? pk2(w.x, w.y) : 0u; }
    }
    PHASE_END(0)
    PHASE_BEGIN(2)
    {
        for (int i = bx * 512 + tid; i < 2 * 4 * 6144; i += G * 512) { const int l = i / (4 * 6144), n = i % 6144; float s = A_IN(19)[l * 6144 + n];
#pragma unroll
            for (int ks = 0; ks < 16; ++ks) s += MODP[(size_t)ks * 2 * 4 * 6144 + i];
            MOD[i] = s; }
        LAS float* mv = (LAS float*)ldsl;
        for (int i = tid; i < 4 * 512; i += 512) { const int b = i >> 9, c4 = (i & 511) * 4; f32x4 s = *(const f32x4*)(A_IN(19) + c4);
#pragma unroll
            for (int ks = 0; ks < 16; ++ks) s += *(const f32x4*)(MODP + ((size_t)(ks * 2) * 4 + b) * 6144 + c4);
            *(LAS f32x4*)(mv + b * 2048 + c4) = s; }
        constexpr int RSW = 2064;
        LAS unsigned char* wfb = ldsl + 32768;
        for (int i = tid; i < 2048; i += 512) { const int h = i >> 7, c = i & 127; *(LAS v4u*)(wfb + h * RSW + c * 16) = *(const v4u*)(WFI + (size_t)(4096 + h) * D + c * 8); }
        __syncthreads();
        const int fr = lane & 15, fq = lane >> 4;
        for (int m0 = gw; m0 < M; m0 += 16 * NGW) {
            for (int i = 0; i < 16; ++i) { int m = m0 + i * NGW; m = m < M ? m : M - 1; const int b = m >> 13;
                const GAS f32x4* xr = (const GAS f32x4*)(x_in + (size_t)m * D) + lane; f32x4 v[4]; float s = 0.f;
#pragma unroll
                for (int j = 0; j < 4; ++j) { v[j] = xr[64 * j]; s += (v[j].x * v[j].x + v[j].y * v[j].y) + (v[j].z * v[j].z + v[j].w * v[j].w); }
                const float rstd = 1.0f / sqrtf(wave_sum(s) * (1.f / D) + EPS);
                GAS v2u* o8 = (GAS v2u*)(HN + (size_t)m * D) + lane;
#pragma unroll
                for (int j = 0; j < 4; ++j) { const int c = 4 * lane + 256 * j; const f32x4 gg = *(const f32x4*)(A_IN(20) + c), s0 = *(LAS f32x4*)(mv + b * 2048 + c), s1 = *(LAS f32x4*)(mv + b * 2048 + 1024 + c);
                    const f32x4 y = v[j] * rstd * gg * (s1 + 1.0f) + s0; v2u w; w.x = pk2(y.x, y.y); w.y = pk2(y.z, y.w); o8[64 * j] = w; } }
            asm volatile("s_waitcnt vmcnt(0)" ::: "memory");
            int mr = m0 + fr * NGW; const bool mok = mr < M; mr = mok ? mr : M - 1;
            f32x4 acc = {0.f, 0.f, 0.f, 0.f}; const bf16* arow = HN + (size_t)mr * D + 8 * fq;
#pragma unroll 8
            for (int ks = 0; ks < 32; ++ks) { const bf16x8 af = *(const GAS bf16x8*)(arow + 32 * ks); const bf16x8 wf = *(const LAS bf16x8*)(wfb + fr * RSW + (32 * ks + 8 * fq) * 2);
                acc = __builtin_amdgcn_mfma_f32_16x16x32_bf16(wf, af, acc, 0, 0, 0); }
            const f32x4 bb = *(const f32x4*)(A_IN(3) + 4 * fq); const int srow = mr & 8191, b = mr >> 13;
            if (mok)
#pragma unroll
            for (int j = 0; j < 4; ++j) { const float x = acc[j] + bb[j]; const float lf = fminf(x, 0.f) - __logf(1.0f + __expf(-fabsf(x))); LOGF[((size_t)(b * 16 + 4 * fq + j) << 13) + srow] = lf; }
        }
        __syncthreads();
    }
    PHASE_END(2)
    PHASE_BEGIN(3)
    { pg8::Gemm g{HN, WFI, M, 4096, D}; pg8::StaticOrder S; S.init(M, 4096, G, bx);
      pg8::EpiFoxIn E{QB, KB, VB, GB, LOGF, A_IN(4), A_IN(5), A_IN(3)};
      pg8::gemm_phase<pg8::EpiFoxIn, pg8::StaticOrder, true, true>(ldsl, g, S, E);
      { const int nwg = (M / 256) * 16, rem = nwg % G;
        if (rem != 0 && bx >= rem) { LAS float* scr = (LAS float*)(ldsl + wave * 16640);
            for (int it = CV_G2 + (bx - rem) * NWAVES + wave; it < CV_G3; it += (G - rem) * NWAVES) CONVERT_ITEM(it, scr); }
        else if (rem == 0) { LAS float* scr = (LAS float*)(ldsl + wave * 16640); for (int it = CV_G2 + gw; it < CV_G3; it += NGW) CONVERT_ITEM(it, scr); } } }
    PHASE_END(3)
    PHASE_BEGIN(4)
    for (int bh = vcu; bh < 64; bh += G) {
        LAS float* Fl = (LAS float*)ldsl; LAS float* wt = (LAS float*)(ldsl + 32768);
        const float* src = LOGF + (size_t)bh * SEQ + tid * 16; f32x4 v[4];
#pragma unroll
        for (int j = 0; j < 4; ++j) v[j] = *(const f32x4*)(src + 4 * j);
        float p[16]; float run = 0.f;
#pragma unroll
        for (int j = 0; j < 4; ++j) { run += v[j].x; p[4 * j] = run; run += v[j].y; p[4 * j + 1] = run; run += v[j].z; p[4 * j + 2] = run; run += v[j].w; p[4 * j + 3] = run; }
        float inc = run;
#pragma unroll
        for (int o = 1; o < 64; o <<= 1) { const float t = __shfl_up(inc, o); if (lane >= o) inc += t; }
        if (lane == 63) wt[wave] = inc;
        __syncthreads();
        float offs = inc - run;
        for (int w = 0; w < wave; ++w) offs += wt[w];
#pragma unroll
        for (int j = 0; j < 4; ++j) { f32x4 o; o.x = (offs + p[4 * j]) * 1.4426950409f; o.y = (offs + p[4 * j + 1]) * 1.4426950409f; o.z = (offs + p[4 * j + 2]) * 1.4426950409f; o.w = (offs + p[4 * j + 3]) * 1.4426950409f;
            *(f32x4*)(FB + (size_t)bh * SEQ + tid * 16 + 4 * j) = o; *(LAS f32x4*)(Fl + tid * 16 + 4 * j) = o; }
        __syncthreads();
        if (tid < 32) {
            float gq = 0.f, gk = 0.f;
            for (int i = 0; i < 64; ++i) { gq = fmaxf(gq, fabsf(A_IN(4)[i])); gk = fmaxf(gk, fabsf(A_IN(5)[i])); }
            const float thr = 40.0f + 2.0f * 64.0f * 0.18033688f * gq * gk;
            const int qb = tid, q0 = 256 * qb; int t0 = 4 * qb; const float fq0 = Fl[q0];
            while (t0 > 0 && !(Fl[64 * t0 - 1] - fq0 > thr)) t0 -= 2;
            T0[bh * 32 + qb] = t0;
        }
        __syncthreads();
    }
    PHASE_END(4)
    PHASE_BEGIN(5)
    { static_assert((long)WS_K - (long)WS_Q == 2 * attn_body::K_OFF && (long)WS_V - (long)WS_Q == 2 * attn_body::V_OFF && (long)WS_G - (long)WS_Q == 2 * attn_body::G_OFF && (long)WS_HN - (long)WS_Q == 2 * attn_body::O_OFF, "attention operand offsets");
      const attn_body::AttnTensors AT{(attn_body::bf16*)QB, FB, T0};
      LAS int* cntw = (LAS int*)(ldsl + 120832); LAS int* tot = cntw + 512; LAS int* sorted = tot + 64; LAS int* mine = sorted + 2048;
      cntw[tid] = 0;
      __syncthreads();
      int key[4];
#pragma unroll
      for (int j = 0; j < 4; ++j) { const int un = 4 * tid + j; const int nt = 4 * (un & 31) + 4 - T0[un]; key[j] = 64 - (nt >> 1); atomicAdd((int*)(cntw + wave * 64 + key[j]), 1); }
      __syncthreads();
      if (tid < 64) { int run = 0; for (int w = 0; w < 8; ++w) { const int c = cntw[w * 64 + tid]; cntw[w * 64 + tid] = run; run += c; } tot[tid] = run; }
      __syncthreads();
      if (tid == 0) { int run = 0; for (int k = 0; k < 64; ++k) { const int c = tot[k]; tot[k] = run; run += c; } }
      __syncthreads();
      { int rank[4] = {0, 0, 0, 0}; const unsigned long long lt = (1ull << lane) - 1ull;
        for (int b = 0; b < 64; ++b) {
            const unsigned long long m0 = __ballot(key[0] == b), m1 = __ballot(key[1] == b), m2 = __ballot(key[2] == b), m3 = __ballot(key[3] == b);
            if ((m0 | m1 | m2 | m3) == 0ull) continue;
            const int lower = __popcll(m0 & lt) + __popcll(m1 & lt) + __popcll(m2 & lt) + __popcll(m3 & lt);
            int same = 0;
#pragma unroll
            for (int j = 0; j < 4; ++j) if (key[j] == b) { rank[j] = lower + same; ++same; }
        }
#pragma unroll
        for (int j = 0; j < 4; ++j) sorted[tot[key[j]] + cntw[wave * 64 + key[j]] + rank[j]] = 4 * tid + j; }
      __syncthreads();
      const int nrounds = (2048 + G - 1) / G; int nmine = 0;
      for (int r = 0; r < nrounds; ++r) { const int j = r * G + ((r & 1) ? (G - 1 - vcu) : vcu); if (j < 2048) { if (tid == 0) { const int un = sorted[j]; mine[nmine] = un | (T0[un] << 16); } ++nmine; } }
      __syncthreads();
      const attn_body::StaticOrder S((const int*)mine, nmine);
      attn_body::attn_phase<attn_body::StaticOrder, 14>((char*)lds, AT, S); }
    PHASE_END(5)
    PHASE_BEGIN(6)
    { pg8::Gemm g{HN, WFO, M, D, D}; pg8::StaticOrder S; S.init(M, D, G, bx);
      pg8::EpiRes<true> E{x_in, X1H, MODV(0, 2)};
      pg8::gemm_phase<pg8::EpiRes<true>, pg8::StaticOrder, true, true>(ldsl, g, S, E); }
    PHASE_END(6)
#define FFN_BLOCK(l, XIN, XOUT, PB) \
    PHASE_BEGIN(PB) \
    for (int m = gw; m < M; m += NGW) { const int b = m >> 13; norm_row_bf16((XIN) + (size_t)m * D, A_IN(21) + (l) * D, MODV(l, 3) + b * 6144, MODV(l, 4) + b * 6144, HN + (size_t)m * D, lane); } \
    PHASE_END(PB) \
    PHASE_BEGIN((PB) + 1) \
    { pg8::Gemm g{HN - 2 * D, (const bf16*)(ws + ((l) ? WS_WUP1 : WS_WUP0)), 136 * 256, 5632, D}; pg8::StaticOrder S; S.init(136 * 256, 5632, G, bx); \
      pg8::EpiFfnUp E{ACT, A_IN(15) + (size_t)(l) * 3 * 5632, A_IN(16) + (size_t)(l) * 5632}; \
      pg8::gemm_phase<pg8::EpiFfnUp, pg8::StaticOrder, true, true, true>(ldsl, g, S, E); \
      if ((l) == 0) { const int rem = (136 * 22) % G; LAS float* scr = (LAS float*)(ldsl + wave * 16640);     \
        if (rem != 0) { if (bx >= rem) for (int it = CV_G3 + (bx - rem) * NWAVES + wave; it < CV_END; it += (G - rem) * NWAVES) CONVERT_ITEM(it, scr); } \
        else for (int it = CV_G3 + gw; it < CV_END; it += NGW) CONVERT_ITEM(it, scr); } } \
    PHASE_END((PB) + 1) \
    PHASE_BEGIN((PB) + 2) \
    { pg8::Gemm g{ACT, (const bf16*)(ws + ((l) ? WS_WDN1 : WS_WDN0)), M, D, DFF}; pg8::StaticOrder S; S.init(M, D, G, bx); \
      pg8::EpiRes<false> E{(XIN), (XOUT), MODV(l, 5)}; \
      pg8::gemm_phase<pg8::EpiRes<false>, pg8::StaticOrder, true, true>(ldsl, g, S, E); } \
    PHASE_END((PB) + 2)
    FFN_BLOCK(0, X1H, X2H, 7)
    PHASE_BEGIN(10)
    for (int m = gw; m < M; m += NGW) { const int b = m >> 13; norm_row_bf16(X2H + (size_t)m * D, A_IN(20) + D, MODV(1, 0) + b * 6144, MODV(1, 1) + b * 6144, HN + (size_t)m * D, lane); }
    PHASE_END(10)
    PHASE_BEGIN(11)
    { pg8::Gemm g{HN, WSI, M, 4096, D}; pg8::StaticOrder S; S.init(M, 4096, G, bx);
      pg8::EpiSguIn E{UB, VS, A_IN(8), STATS};
      pg8::gemm_phase<pg8::EpiSguIn, pg8::StaticOrder, true, true>(ldsl, g, S, E); }
    PHASE_END(11)
    PHASE_BEGIN(12)
    {
        constexpr int RS = 272, OFF_B = 128 * RS, OFF_ST = OFF_B + 256 * RS;
        const int g = bx & 7;
        for (int i = tid; i < 128 * 16; i += 512) { const int r = i >> 4, c = i & 15; *(LAS v4u*)(ldsl + r * RS + c * 16) = *(const v4u*)(WSM + ((size_t)g * 128 + r) * 128 + c * 8); }
        const int cc = tid & 31; float gn[8], bs[8];
#pragma unroll
        for (int e = 0; e < 8; ++e) { gn[e] = A_IN(9)[g * 256 + 8 * cc + e]; bs[e] = A_IN(10)[g * 256 + 8 * cc + e]; }
        const int fr = lane & 15, fq = lane >> 4, wm = wave >> 2, wn = wave & 3;
        LAS f32x2* ST = (LAS f32x2*)(ldsl + OFF_ST);
        v4u va[4], vb[4]; f32x4 sq[4];
#define MIX_LOAD(IDX) do { const size_t rb_ = (size_t)((IDX) >> 3) * 128; \
            _Pragma("unroll") for (int it = 0; it < 4; ++it) { const int sp = (it * 512 + tid) >> 5; const bf16* vp = VS + (rb_ + 2 * sp) * SGW + g * 256 + 8 * cc; va[it] = *(const v4u*)vp; vb[it] = *(const v4u*)(vp + SGW); } \
            { const float* sp_ = STATS + (rb_ + (tid >> 2)) * 64 + (tid & 3) * 16; _Pragma("unroll") for (int j = 0; j < 4; ++j) sq[j] = *(const f32x4*)(sp_ + 4 * j); } } while (0)
        float bsv4[4];
#pragma unroll
        for (int m = 0; m < 4; ++m) bsv4[m] = A_IN(12)[g * 128 + 64 * wm + 16 * m + fr];
        int idx = bx; if (idx < 2048) MIX_LOAD(idx);
        for (; idx < 2048; idx += G) {
            const int bn = idx >> 3; const size_t rowbase = (size_t)bn * 128;
            { float s1 = 0.f, s2 = 0.f;
#pragma unroll
              for (int j = 0; j < 4; ++j) { s1 += sq[j].x + sq[j].z; s2 += sq[j].y + sq[j].w; }
              s1 += __shfl_xor(s1, 1); s1 += __shfl_xor(s1, 2); s2 += __shfl_xor(s2, 1); s2 += __shfl_xor(s2, 2);
              if ((tid & 3) == 0) { const float mu = s1 * (1.f / SGW); const float var = fmaxf(s2 * (1.f / SGW) - mu * mu, 0.f); ST[tid >> 2] = (f32x2){mu, 1.0f / sqrtf(var + EPS)}; } }
            __syncthreads();
#pragma unroll
            for (int it = 0; it < 4; ++it) { const int sp = (it * 512 + tid) >> 5; const v4u a = va[it], b = vb[it]; const f32x2 st0 = ST[2 * sp], st1 = ST[2 * sp + 1];
#pragma unroll
                for (int e = 0; e < 8; ++e) { const unsigned wa = a[e >> 1], wb = b[e >> 1]; const float x0 = (e & 1) ? bfhi(wa) : bflo(wa), x1 = (e & 1) ? bfhi(wb) : bflo(wb);
                    const float y0 = (x0 - st0.x) * st0.y * gn[e] + bs[e], y1 = (x1 - st1.x) * st1.y * gn[e] + bs[e];
                    *(LAS unsigned*)(ldsl + OFF_B + (8 * cc + e) * RS + ((((sp >> 2) ^ (cc & 7)) << 2) | (sp & 3)) * 4) = pk2(y0, y1); } }
            __syncthreads();
            { const int nidx = idx + G; if (nidx < 2048) MIX_LOAD(nidx); }
            f32x4 acc[4][4];
#pragma unroll
            for (int m = 0; m < 4; ++m)
#pragma unroll
                for (int n = 0; n < 4; ++n) acc[m][n] = (f32x4){0.f, 0.f, 0.f, 0.f};
#pragma unroll
            for (int kk = 0; kk < 4; ++kk) {
                if (wm == 0 && kk >= 2) continue;
                bf16x8 Af[4], Bf[4];
#pragma unroll
                for (int m = 0; m < 4; ++m) Af[m] = *(const LAS bf16x8*)(ldsl + (64 * wm + 16 * m + fr) * RS + (32 * kk + 8 * fq) * 2);
#pragma unroll
                for (int n = 0; n < 4; ++n) { const int crow = 64 * wn + 32 * (n >> 1) + 8 * (fr >> 2) + 4 * (n & 1) + (fr & 3); Bf[n] = *(const LAS bf16x8*)(ldsl + OFF_B + crow * RS + (((4 * kk + fq) ^ ((crow >> 3) & 7)) << 4)); }
#pragma unroll
                for (int m = 0; m < 4; ++m)
#pragma unroll
                    for (int n = 0; n < 4; ++n) acc[m][n] = __builtin_amdgcn_mfma_f32_16x16x32_bf16(Bf[n], Af[m], acc[m][n], 0, 0, 0);
            }
            v4u uu[4][2];
#pragma unroll
            for (int m = 0; m < 4; ++m)
#pragma unroll
                for (int p = 0; p < 2; ++p) uu[m][p] = *(const v4u*)(UB + (rowbase + 64 * wm + 16 * m + fr) * SGW + g * 256 + 64 * wn + 32 * p + 8 * fq);
#pragma unroll
            for (int m = 0; m < 4; ++m) { const int t = 64 * wm + 16 * m + fr; const float bsv = bsv4[m];
#pragma unroll
                for (int p = 0; p < 2; ++p) { bf16* up = UB + (rowbase + t) * SGW + g * 256 + 64 * wn + 32 * p + 8 * fq; v4u o;
#pragma unroll
                    for (int e = 0; e < 4; ++e) { const f32x4 lo4 = acc[m][2 * p], hi4 = acc[m][2 * p + 1];
                        const float m0 = ((e < 2) ? lo4[2 * e] : hi4[2 * e - 4]) + bsv, m1 = ((e < 2) ? lo4[2 * e + 1] : hi4[2 * e - 3]) + bsv;
                        o[e] = pk2(pg8::gelu_tanh(bflo(uu[m][p][e])) * m0, pg8::gelu_tanh(bfhi(uu[m][p][e])) * m1); }
                    if (rep_ == (int)((REPMASK >> 12) & 1ull)) *(v4u*)up = o; } }
            __syncthreads();
        }
#undef MIX_LOAD
    }
    PHASE_END(12)
    PHASE_BEGIN(13)
    { pg8::Gemm g{UB, WSO, M, D, SGW}; pg8::StaticOrder S; S.init(M, D, G, bx);
      pg8::EpiRes<false> E{X2H, X1H, MODV(1, 2)};
      pg8::gemm_phase<pg8::EpiRes<false>, pg8::StaticOrder, true, true>(ldsl, g, S, E); }
    PHASE_END(13)
    FFN_BLOCK(1, X1H, X2H2, 14)
    PHASE_BEGIN(17)
    for (int m = gw; m < M; m += NGW) { const unsigned short* xrow = X2H2 + (size_t)m * D; const v4u a = *(const GAS v4u*)(xrow + 8 * lane), b = *(const GAS v4u*)(xrow + 512 + 8 * lane); float v[16]; float s = 0.f;
#pragma unroll
        for (int i = 0; i < 4; ++i) { v[2 * i] = pg8::h_lo(a[i]); v[2 * i + 1] = pg8::h_hi(a[i]); v[8 + 2 * i] = pg8::h_lo(b[i]); v[8 + 2 * i + 1] = pg8::h_hi(b[i]); }
#pragma unroll
        for (int i = 0; i < 16; ++i) s += v[i] * v[i];
        const float rstd = 1.0f / sqrtf(wave_sum(s) * (1.f / D) + EPS);
#pragma unroll
        for (int h = 0; h < 2; ++h)
#pragma unroll
            for (int q = 0; q < 2; ++q) { const int c = 512 * h + 8 * lane + 4 * q; const f32x4 gg = *(const f32x4*)(A_IN(22) + c);
                const f32x4 x4 = {v[8 * h + 4 * q], v[8 * h + 4 * q + 1], v[8 * h + 4 * q + 2], v[8 * h + 4 * q + 3]}; *(GAS f32x4*)(out + (size_t)m * D + c) = x4 * rstd * gg; } }
    PHASE_END(17)
}

#undef ws
#undef out
#undef x_in
#undef T0
#undef A_IN
extern "C" void kernel_launch(void* const* d_in, const int* in_sizes, int n_in, void* d_out, int out_size, void* d_ws, size_t ws_size, hipStream_t stream) {
    static int grid = 0;
    if (grid == 0) {
        if (n_in != 23 || in_sizes[0] != M * D || out_size != M * D || ws_size < WS_END) { fprintf(stderr, "kernel_launch: unexpected shapes/workspace (n_in %d, in0 %d, out %d, ws %zu); nothing launched\n", n_in, n_in > 0 ? in_sizes[0] : -1, out_size, ws_size); grid = -1; return; }
        int dev = 0, cus = 0, per_cu = 0;
        if (hipGetDevice(&dev) != hipSuccess || hipDeviceGetAttribute(&cus, hipDeviceAttributeMultiprocessorCount, dev) != hipSuccess) { grid = -1; return; }
        if (hipFuncSetAttribute((const void*)fwd_mega, hipFuncAttributeMaxDynamicSharedMemorySize, LDS_BYTES) != hipSuccess) { fprintf(stderr, "kernel_launch: hipFuncSetAttribute failed\n"); grid = -1; return; }
        if (hipOccupancyMaxActiveBlocksPerMultiprocessor(&per_cu, (const void*)fwd_mega, NWAVES * 64, LDS_BYTES) != hipSuccess || per_cu < 1) { fprintf(stderr, "kernel_launch: occupancy query says %d blocks per CU\n", per_cu); per_cu = 1; }
        (void)hipGetLastError();
        grid = cus;
        if (grid % 8 != 0) grid -= grid % 8;
    }
    if (grid <= 0) return;
    if (hipMemsetAsync((char*)d_ws + WS_CTL, 0, CTL_ZERO_BYTES, stream) != hipSuccess) { fprintf(stderr, "kernel_launch: hipMemsetAsync failed\n"); return; }
    Args a{};
    for (int i = 0; i < 23; ++i) a.in[i] = (const float*)d_in[i];
    a.out = (float*)d_out; a.ws = (unsigned char*)d_ws; a.ph_lo = 0; a.ph_hi = 1000;
    void* kargs[] = {&a};
    hipError_t e = hipLaunchCooperativeKernel((const void*)fwd_mega, dim3(grid), dim3(NWAVES * 64), kargs, LDS_BYTES, stream);
    if (e != hipSuccess) fprintf(stderr, "kernel_launch: cooperative launch failed: %s (grid %d)\n", hipGetErrorString(e), grid);
}
```

```cpp
#include <hip/hip_runtime.h>
#include <hip/hip_cooperative_groups.h>
#include <cstdio>
#include <cstdint>
namespace pg8 {
#define PG8_LAS __attribute__((address_space(3)))
typedef unsigned short bf16_t;
typedef short bf16x8 __attribute__((ext_vector_type(8)));
typedef float f32x4 __attribute__((ext_vector_type(4)));
typedef unsigned u32x4 __attribute__((ext_vector_type(4)));
constexpr int BM = 256, BK = 64, HALF = 128, HTB = HALF * BK * 2  , STAGE_BYTES = 8 * HTB, NXCD = 8, WGM = 8;

__host__ __device__ __forceinline__ int lds_byte(int r, int c) { const int st = (r >> 4) * 2 + (c >> 5), rr = r & 15, cc = c & 31, ob = rr * 64 + cc * 2; return st * 1024 + (ob ^ (((ob >> 9) & 1) << 5)); }
__host__ __device__ __forceinline__ void stage_rc(int b, int& R, int& C) { const int st = b / 1024, sb = b % 1024, swz = sb ^ (((sb >> 9) & 1) << 5); R = (st >> 1) * 16 + swz / 64; C = (st & 1) * 32 + (swz % 64) / 2; }
__host__ __device__ __forceinline__ int perm32(int rho) { const int n = rho >> 4, i = rho & 15; return 8 * (i >> 2) + 4 * n + (i & 3); }

struct Unit { int pm, pn; };
struct Gemm { const bf16_t* A; const bf16_t* Bt; int M, N, K; };

struct StaticOrder {
    int nM, nN, nwg, G, c;
    __host__ __device__ void init(int M, int N, int G_, int c_) { nM = M / BM; nN = N / BM; nwg = nM * nN; G = G_; c = c_; }
    __host__ __device__ bool next(int i, Unit& u) const {
        const long L = (long)i * G + c; if (L >= nwg) return false;
        int wgid = (int)L; { const int q = nwg / NXCD, r = nwg % NXCD, xcd = wgid % NXCD, off = wgid / NXCD; wgid = (xcd < r ? xcd * (q + 1) : r * (q + 1) + (xcd - r) * q) + off; }
        const int nig = WGM * nN, gid = wgid / nig, fm = gid * WGM, gsz = (nM - fm) < WGM ? (nM - fm) : WGM;
        u.pm = fm + ((wgid % nig) % gsz); u.pn = (wgid % nig) / gsz; return true;
    }
    __device__ __forceinline__ void a_ready(const Unit&) const {}
    __device__ __forceinline__ void done(const Unit&) const {}
};

__device__ __forceinline__ unsigned cvt_pk_bf16(float lo, float hi) { unsigned r; asm volatile("v_cvt_pk_bf16_f32 %0, %1, %2" : "=v"(r) : "v"(lo), "v"(hi)); return r; }
typedef _Float16 f16x2_t __attribute__((ext_vector_type(2))); typedef float f32x2c_t __attribute__((ext_vector_type(2)));
__device__ __forceinline__ unsigned pk_h2(float lo, float hi) { const f32x2c_t v = {lo, hi}; return __builtin_bit_cast(unsigned, __builtin_convertvector(v, f16x2_t)); }
__device__ __forceinline__ float h_lo(unsigned w) { return (float)__builtin_bit_cast(f16x2_t, w)[0]; }
__device__ __forceinline__ float h_hi(unsigned w) { return (float)__builtin_bit_cast(f16x2_t, w)[1]; }
__device__ __forceinline__ float fast_sigmoid(float x) { return __builtin_amdgcn_rcpf(1.0f + __builtin_amdgcn_exp2f(-1.4426950409f * x)); }
__device__ __forceinline__ float gelu_tanh(float x) { const float t = x * (1.0f + 0.044715f * x * x) * 2.302208198f; return x * __builtin_amdgcn_rcpf(1.0f + __builtin_amdgcn_exp2f(-t)); }
__device__ __forceinline__ void conv_taps(float& acc, float x, float xp, float w1, float w0) {
    asm("s_nop 1\n\t"
        "v_fmac_f32_dpp %0, %1, %3 row_shr:1 row_mask:0xf bank_mask:0xf bound_ctrl:1\n\t"
        "v_fmac_f32_dpp %0, %2, %3 row_shl:15 row_mask:0xf bank_mask:0xf bound_ctrl:1\n\t"
        "v_fmac_f32_dpp %0, %1, %4 row_shr:2 row_mask:0xf bank_mask:0xf bound_ctrl:1\n\t"
        "v_fmac_f32_dpp %0, %2, %4 row_shl:14 row_mask:0xf bank_mask:0xf bound_ctrl:1"
        : "+v"(acc) : "v"(x), "v"(xp), "v"(w1), "v"(w0));
}

struct EpiFoxIn {
    static constexpr bool PERM = true, AFTER_DRAIN = false;
    bf16_t *Q, *Kb, *V, *G; float* LOGF; const float *qg, *kg, *bfg;
    __device__ __forceinline__ void operator()(const f32x4 (&acc)[2][2][4][2], const Unit& u, int wr, int wc, int fr, int fq) const {
        const int row0 = u.pm * BM + wr * 64 + fr; const int pn = u.pn;
        if (pn < 8) {
            const bool isq = pn < 4; const float* gn = isq ? qg : kg; const float post = isq ? 0.18033688011112042f : 1.0f;
            bf16_t* base = (isq ? Q : Kb) + ((pn & 3) * 4 + wc) * 64 + 8 * fq;
            f32x4 gv[2][2];
#pragma unroll
            for (int bj = 0; bj < 2; ++bj)
#pragma unroll
                for (int n = 0; n < 2; ++n) gv[bj][n] = *(const f32x4*)(gn + 32 * bj + 8 * fq + 4 * n) * post;
#pragma unroll
            for (int ai = 0; ai < 2; ++ai)
#pragma unroll
                for (int m = 0; m < 4; ++m) {
                    float ss = 0.f;
#pragma unroll
                    for (int bj = 0; bj < 2; ++bj)
#pragma unroll
                        for (int n = 0; n < 2; ++n) { const f32x4 x = acc[ai][bj][m][n]; ss += (x[0] * x[0] + x[1] * x[1]) + (x[2] * x[2] + x[3] * x[3]); }
                    ss += __shfl_xor(ss, 16); ss += __shfl_xor(ss, 32);
                    const float r = __builtin_amdgcn_rsqf(ss * (1.0f / 64.0f) + 1e-6f);
                    bf16_t* rowp = base + (size_t)(row0 + ai * HALF + m * 16) * 1024;
#pragma unroll
                    for (int bj = 0; bj < 2; ++bj) { const f32x4 v0 = acc[ai][bj][m][0] * r * gv[bj][0], v1 = acc[ai][bj][m][1] * r * gv[bj][1];
                        u32x4 w; w.x = cvt_pk_bf16(v0[0], v0[1]); w.y = cvt_pk_bf16(v0[2], v0[3]); w.z = cvt_pk_bf16(v1[0], v1[1]); w.w = cvt_pk_bf16(v1[2], v1[3]);
                        *(u32x4*)(rowp + 32 * bj) = w; }
                }
        } else if (pn < 16) {
            const bool isv = pn < 12; bf16_t* base = (isv ? V : G) + ((pn & 3) * 4 + wc) * 64 + 8 * fq;
#pragma unroll
            for (int ai = 0; ai < 2; ++ai)
#pragma unroll
                for (int m = 0; m < 4; ++m) { bf16_t* rowp = base + (size_t)(row0 + ai * HALF + m * 16) * 1024;
#pragma unroll
                    for (int bj = 0; bj < 2; ++bj) { f32x4 v0 = acc[ai][bj][m][0], v1 = acc[ai][bj][m][1];
                        if (!isv) {
#pragma unroll
                            for (int j = 0; j < 4; ++j) { v0[j] = fast_sigmoid(v0[j]); v1[j] = fast_sigmoid(v1[j]); } }
                        u32x4 w; w.x = cvt_pk_bf16(v0[0], v0[1]); w.y = cvt_pk_bf16(v0[2], v0[3]); w.z = cvt_pk_bf16(v1[0], v1[1]); w.w = cvt_pk_bf16(v1[2], v1[3]);
                        *(u32x4*)(rowp + 32 * bj) = w; } }
        } else {
            if (wc == 0 && fq < 2) {
#pragma unroll
                for (int n = 0; n < 2; ++n) { const f32x4 bb = *(const f32x4*)(bfg + 8 * fq + 4 * n);
#pragma unroll
                    for (int ai = 0; ai < 2; ++ai)
#pragma unroll
                        for (int m = 0; m < 4; ++m) { const int row = row0 + ai * HALF + m * 16, b = row >> 13, s = row & 8191;
#pragma unroll
                            for (int j = 0; j < 4; ++j) { const float x = acc[ai][0][m][n][j] + bb[j]; const float lf = fminf(x, 0.f) - __logf(1.0f + __expf(-fabsf(x)));
                                LOGF[((size_t)(b * 16 + 8 * fq + 4 * n + j) << 13) + s] = lf; } } }
            }
        }
    }
};
template <bool BASE_F32> struct EpiRes {
    static constexpr bool PERM = true, AFTER_DRAIN = false;
    const void* base; unsigned short* out; const float* gate;
    __device__ __forceinline__ void operator()(const f32x4 (&acc)[2][2][4][2], const Unit& u, int wr, int wc, int fr, int fq) const {
        const float* gb = gate + (u.pm >> 5) * 6144; const int col0 = u.pn * BM + wc * 32 + 8 * fq;
        f32x4 gv[2][2];
#pragma unroll
        for (int bj = 0; bj < 2; ++bj)
#pragma unroll
            for (int n = 0; n < 2; ++n) gv[bj][n] = *(const f32x4*)(gb + col0 + bj * HALF + 4 * n);
#pragma unroll
        for (int ai = 0; ai < 2; ++ai) { const size_t off0 = (size_t)(u.pm * BM + ai * HALF + wr * 64 + fr) * 1024 + col0;
            f32x4 bs[4][2][2];
            if (BASE_F32) {
#pragma unroll
                for (int m = 0; m < 4; ++m)
#pragma unroll
                    for (int bj = 0; bj < 2; ++bj)
#pragma unroll
                        for (int n = 0; n < 2; ++n) bs[m][bj][n] = *(const f32x4*)((const float*)base + off0 + (size_t)m * 16 * 1024 + bj * HALF + 4 * n);
            } else {
                u32x4 bh[4][2];
#pragma unroll
                for (int m = 0; m < 4; ++m)
#pragma unroll
                    for (int bj = 0; bj < 2; ++bj) bh[m][bj] = *(const u32x4*)((const unsigned short*)base + off0 + (size_t)m * 16 * 1024 + bj * HALF);
#pragma unroll
                for (int m = 0; m < 4; ++m)
#pragma unroll
                    for (int bj = 0; bj < 2; ++bj) { bs[m][bj][0] = (f32x4){h_lo(bh[m][bj].x), h_hi(bh[m][bj].x), h_lo(bh[m][bj].y), h_hi(bh[m][bj].y)}; bs[m][bj][1] = (f32x4){h_lo(bh[m][bj].z), h_hi(bh[m][bj].z), h_lo(bh[m][bj].w), h_hi(bh[m][bj].w)}; }
            }
#pragma unroll
            for (int m = 0; m < 4; ++m)
#pragma unroll
                for (int bj = 0; bj < 2; ++bj) { const f32x4 o0 = bs[m][bj][0] + gv[bj][0] * acc[ai][bj][m][0], o1 = bs[m][bj][1] + gv[bj][1] * acc[ai][bj][m][1];
                    u32x4 w; w.x = pk_h2(o0[0], o0[1]); w.y = pk_h2(o0[2], o0[3]); w.z = pk_h2(o1[0], o1[1]); w.w = pk_h2(o1[2], o1[3]);
                    *(u32x4*)(out + off0 + (size_t)m * 16 * 1024 + bj * HALF) = w; }
            asm volatile("" ::: "memory"); }
    }
};
struct EpiSguIn {
    static constexpr bool PERM = true, AFTER_DRAIN = false;
    bf16_t *U, *V; const float* bias; float* stats;
    __device__ __forceinline__ void operator()(const f32x4 (&acc)[2][2][4][2], const Unit& u, int wr, int wc, int fr, int fq) const {
        const int pn = u.pn; const bool isv = pn >= 8; const int row0 = u.pm * BM + wr * 64 + fr;
        const int bcol0 = pn * BM + wc * 32 + 8 * fq; bf16_t* base = (isv ? V : U) + ((pn & 7) * BM + wc * 32 + 8 * fq);
        f32x4 bv[2][2];
#pragma unroll
        for (int bj = 0; bj < 2; ++bj)
#pragma unroll
            for (int n = 0; n < 2; ++n) bv[bj][n] = *(const f32x4*)(bias + bcol0 + bj * HALF + 4 * n);
#pragma unroll
        for (int ai = 0; ai < 2; ++ai)
#pragma unroll
            for (int m = 0; m < 4; ++m) { const int row = row0 + ai * HALF + m * 16; bf16_t* rowp = base + (size_t)row * 2048; float s1 = 0.f, s2 = 0.f;
#pragma unroll
                for (int bj = 0; bj < 2; ++bj) { f32x4 v0 = acc[ai][bj][m][0] + bv[bj][0], v1 = acc[ai][bj][m][1] + bv[bj][1];
                    if (isv) { for (int j = 0; j < 4; ++j) { v0[j] = gelu_tanh(v0[j]); v1[j] = gelu_tanh(v1[j]); } }
                    s1 += ((v0[0] + v0[1]) + (v0[2] + v0[3])) + ((v1[0] + v1[1]) + (v1[2] + v1[3]));
                    s2 += ((v0[0] * v0[0] + v0[1] * v0[1]) + (v0[2] * v0[2] + v0[3] * v0[3])) + ((v1[0] * v1[0] + v1[1] * v1[1]) + (v1[2] * v1[2] + v1[3] * v1[3]));
                    u32x4 w; w.x = cvt_pk_bf16(v0[0], v0[1]); w.y = cvt_pk_bf16(v0[2], v0[3]); w.z = cvt_pk_bf16(v1[0], v1[1]); w.w = cvt_pk_bf16(v1[2], v1[3]);
                    *(u32x4*)(rowp + bj * HALF) = w; }
                if (isv) { s1 += __shfl_xor(s1, 16); s1 += __shfl_xor(s1, 32); s2 += __shfl_xor(s2, 16); s2 += __shfl_xor(s2, 32);
                    if (fq == 0) { typedef float f32x2v __attribute__((ext_vector_type(2))); *(f32x2v*)(stats + ((size_t)row * 32 + (pn - 8) * 4 + wc) * 2) = (f32x2v){s1, s2}; } } }
    }
};
struct EpiFfnUp {
    static constexpr bool PERM = true, AFTER_DRAIN = false;
    bf16_t* ACT; const float *cw, *cb;
    __device__ __forceinline__ void operator()(const f32x4 (&acc)[2][2][4][2], const Unit& u, int wr, int wc, int fr, int fq) const {
        const int b = u.pm / 34, pmb = u.pm % 34; const int ch0 = u.pn * 128 + wc * 32 + 8 * fq;
        typedef unsigned u32x2v __attribute__((ext_vector_type(2)));
        u32x2v pk[2][4];
#pragma unroll
        for (int n = 0; n < 2; ++n) {
            const float* cwp = cw + ch0 + 4 * n; const float* cbp = cb + ch0 + 4 * n;
            const f32x4 w0g = *(const f32x4*)(cwp), w1g = *(const f32x4*)(cwp + 5632), w2g = *(const f32x4*)(cwp + 2 * 5632), bg = *(const f32x4*)(cbp);
            const f32x4 w0v = *(const f32x4*)(cwp + 2816), w1v = *(const f32x4*)(cwp + 5632 + 2816), w2v = *(const f32x4*)(cwp + 2 * 5632 + 2816), bvv = *(const f32x4*)(cbp + 2816);
#pragma unroll
            for (int ai = 0; ai < 2; ++ai) { const int j = 2 * ai + wr; const bool first = (pmb == 0) && (j == 0); const int tb = 248 * pmb + 62 * j - 2 + fr;
                f32x4 pg, pv;
#pragma unroll
                for (int m = 0; m < 4; ++m) { f32x4 g = acc[ai][0][m][n], v = acc[ai][1][m][n];
                    if (m == 0) { if (first && fr < 2) { g = (f32x4){0.f, 0.f, 0.f, 0.f}; v = g; } pg = g; pv = v; }
                    f32x4 r;
#pragma unroll
                    for (int c = 0; c < 4; ++c) {
                        float cg = w2g[c] * g[c] + bg[c]; conv_taps(cg, g[c], pg[c], w1g[c], w0g[c]);
                        float cv = w2v[c] * v[c] + bvv[c]; conv_taps(cv, v[c], pv[c], w1v[c], w0v[c]);
                        r[c] = cg * cv * fast_sigmoid(cg); }
                    pg = g; pv = v;
                    u32x2v w; w.x = cvt_pk_bf16(r[0], r[1]); w.y = cvt_pk_bf16(r[2], r[3]);
                    if (n == 0) pk[ai][m] = w;
                    else { const int t = tb + 16 * m; if ((m > 0 || fr >= 2) && t < 8192) { u32x4 o; o.x = pk[ai][m].x; o.y = pk[ai][m].y; o.z = w.x; o.w = w.y;
                            *(u32x4*)(ACT + ((size_t)b * 8192 + t) * 2816 + ch0) = o; } }
                } }
        }
    }
};

template <class Epi, class Sched, bool ALIGN_EPI = false, bool SP2 = false, bool OVL = false>
__device__ __forceinline__ void gemm_phase(PG8_LAS unsigned char* lds, const Gemm g, const Sched& S, const Epi& E) {
    const int tid = threadIdx.x, wid = __builtin_amdgcn_readfirstlane(tid >> 6), lane = tid & 63, wr = wid >> 2, wc = wid & 3, fr = lane & 15, fq = lane >> 4;
    const int K = g.K, nt = K / BK;
    unsigned voffA[2], voffB[2];
#pragma unroll
    for (int i = 0; i < 2; ++i) { int R, C; stage_rc(tid * 16 + i * 8192, R, C); const int Rb = Epi::PERM ? ((R & ~31) + perm32(R & 31)) : R;
        { const int Ra = OVL ? (R - 2 * (R >> 6)) : R; voffA[i] = (unsigned)(Ra * K + C) * 2u; } voffB[i] = (unsigned)(Rb * K + C) * 2u; }
    const size_t kstep = (size_t)(BK * 2);
    const size_t hstep = (size_t)HALF * K * 2;
    const size_t tstep = 2 * hstep;
    const size_t hstepA = OVL ? (size_t)124 * K * 2 : hstep;
#define PG8_AOFF(pm) (OVL ? ((size_t)((pm) / 34) * 8192 + (size_t)((pm) % 34) * 248) * (size_t)K * 2 : (size_t)(pm) * tstep)
    const unsigned ldsw = (unsigned)wid * 1024u;
    const int aoff = lds_byte(wr * 64 + fr, fq * 8), boff = lds_byte(wc * 32 + fr, fq * 8);
#define PG8_SA(b, h) (((b) * 2 + (h)) * HTB)
#define PG8_SB(b, h) ((4 + (b) * 2 + (h)) * HTB)
#define PG8_STAGE(bufoff, gbase, voff) do { _Pragma("unroll") for (int _i = 0; _i < 2; ++_i) \
        __builtin_amdgcn_global_load_lds((const unsigned*)((const char*)(gbase) + (voff)[_i]), (PG8_LAS unsigned*)(lds + (bufoff) + ldsw + _i * 8192), 16, 0, 0); } while (0)
#define PG8_LDA(dst, b, h) do { _Pragma("unroll") for (int m = 0; m < 4; ++m) _Pragma("unroll") for (int k = 0; k < 2; ++k) dst[m][k] = *(const PG8_LAS bf16x8*)(lds + PG8_SA(b, h) + aoff + m * 2048 + k * 1024); } while (0)
#define PG8_LDB(dst, b, h) do { _Pragma("unroll") for (int n = 0; n < 2; ++n) _Pragma("unroll") for (int k = 0; k < 2; ++k) dst[n][k] = *(const PG8_LAS bf16x8*)(lds + PG8_SB(b, h) + boff + n * 2048 + k * 1024); } while (0)
#define PG8_MMA(ai, bj, At, Bt) do { __builtin_amdgcn_s_setprio(1); _Pragma("unroll") for (int m = 0; m < 4; ++m) _Pragma("unroll") for (int n = 0; n < 2; ++n) _Pragma("unroll") for (int k = 0; k < 2; ++k) \
        acc[ai][bj][m][n] = __builtin_amdgcn_mfma_f32_16x16x32_bf16(Bt[n][k], At[m][k], acc[ai][bj][m][n], 0, 0, 0); __builtin_amdgcn_s_setprio(0); } while (0)
#define PG8_WAIT_V(n) asm volatile("s_waitcnt vmcnt(" #n ")" ::: "memory")
#define PG8_WAIT_L(n) asm volatile("s_waitcnt lgkmcnt(" #n ")" ::: "memory")
#define PG8_BAR __builtin_amdgcn_s_barrier()
#define PG8_SCHED __builtin_amdgcn_sched_barrier(0)
    Unit cur, nxt; int ui = 0;
    if (!S.next(0, cur)) return;
    f32x4 acc[2][2][4][2];
#pragma unroll
    for (int a = 0; a < 2; ++a)
#pragma unroll
        for (int b = 0; b < 2; ++b)
#pragma unroll
            for (int m = 0; m < 4; ++m)
#pragma unroll
                for (int n = 0; n < 2; ++n) acc[a][b][m][n] = (f32x4){0.f, 0.f, 0.f, 0.f};
    bf16x8 At[4][2], B0[2][2], B1[2][2];
    const char* cA = (const char*)g.A + PG8_AOFF(cur.pm); const char* cB = (const char*)g.Bt + (size_t)cur.pn * tstep;
    S.a_ready(cur);
    if constexpr (SP2) {
        PG8_STAGE(PG8_SB(0, 0), cB, voffB); PG8_STAGE(PG8_SB(0, 1), cB + hstep, voffB); PG8_STAGE(PG8_SA(0, 0), cA, voffA); PG8_STAGE(PG8_SA(0, 1), cA + hstepA, voffA);
        if (wr == 1) PG8_BAR;
        PG8_WAIT_V(2); PG8_BAR;
        PG8_STAGE(PG8_SB(1, 0), cB + kstep, voffB); PG8_STAGE(PG8_SA(1, 0), cA + kstep, voffA); PG8_STAGE(PG8_SB(1, 1), cB + hstep + kstep, voffB);
        PG8_WAIT_V(6); PG8_BAR;
    } else {
        PG8_STAGE(PG8_SB(0, 0), cB, voffB); PG8_STAGE(PG8_SA(0, 0), cA, voffA); PG8_STAGE(PG8_SB(0, 1), cB + hstep, voffB); PG8_STAGE(PG8_SA(0, 1), cA + hstepA, voffA);
        if (wr == 1) PG8_BAR;
        PG8_WAIT_V(4); PG8_BAR;
        PG8_STAGE(PG8_SB(1, 0), cB + kstep, voffB); PG8_STAGE(PG8_SA(1, 0), cA + kstep, voffA); PG8_STAGE(PG8_SB(1, 1), cB + hstep + kstep, voffB);
        PG8_WAIT_V(6); PG8_BAR;
    }
    for (;;) {
        const bool has_next = S.next(ui + 1, nxt);
        const char* nA = has_next ? (const char*)g.A + PG8_AOFF(nxt.pm) : cA; const char* nB = has_next ? (const char*)g.Bt + (size_t)nxt.pn * tstep : cB;
        for (int t = 0; t < nt; t += 2) {
            const bool last = (t == nt - 2);
            const char* a1 = cA + (size_t)(t + 1) * kstep;
            const char* a2 = last ? nA : cA + (size_t)(t + 2) * kstep; const char* b2 = last ? nB : cB + (size_t)(t + 2) * kstep;
            const char* a3 = a2 + kstep; const char* b3 = b2 + kstep;
            if (last && has_next) S.a_ready(nxt);
            if constexpr (SP2) {
            PG8_LDB(B0, 0, 0); PG8_LDB(B1, 0, 1); PG8_SCHED; PG8_LDA(At, 0, 0); PG8_STAGE(PG8_SA(1, 1), a1 + hstepA, voffA);
            PG8_WAIT_V(8); PG8_WAIT_L(0); PG8_BAR; PG8_MMA(0, 0, At, B0); PG8_MMA(0, 1, At, B1); PG8_BAR; PG8_SCHED;
            PG8_LDA(At, 0, 1); PG8_STAGE(PG8_SB(0, 0), b2, voffB); PG8_STAGE(PG8_SB(0, 1), b2 + hstep, voffB); PG8_STAGE(PG8_SA(0, 0), a2, voffA);
            PG8_WAIT_V(8); PG8_WAIT_L(0); PG8_BAR; PG8_MMA(1, 0, At, B0); PG8_MMA(1, 1, At, B1); PG8_BAR; PG8_SCHED;
            PG8_LDB(B0, 1, 0); PG8_LDB(B1, 1, 1); PG8_SCHED; PG8_LDA(At, 1, 0); PG8_STAGE(PG8_SA(0, 1), a2 + hstepA, voffA);
            PG8_WAIT_V(8); PG8_WAIT_L(0); PG8_BAR; PG8_MMA(0, 0, At, B0); PG8_MMA(0, 1, At, B1); PG8_BAR; PG8_SCHED;
            PG8_LDA(At, 1, 1); PG8_STAGE(PG8_SB(1, 0), b3, voffB); PG8_STAGE(PG8_SB(1, 1), b3 + hstep, voffB); PG8_STAGE(PG8_SA(1, 0), a3, voffA);
            PG8_WAIT_V(8); PG8_WAIT_L(0); PG8_BAR; PG8_MMA(1, 0, At, B0); PG8_MMA(1, 1, At, B1); PG8_BAR; PG8_SCHED;
            } else {
            PG8_LDB(B0, 0, 0); PG8_SCHED; PG8_LDA(At, 0, 0); PG8_STAGE(PG8_SA(1, 1), a1 + hstepA, voffA);
            PG8_WAIT_L(8); PG8_BAR; PG8_WAIT_L(0); PG8_MMA(0, 0, At, B0); PG8_BAR; PG8_SCHED;
            PG8_LDB(B1, 0, 1); PG8_STAGE(PG8_SB(0, 0), b2, voffB);
            PG8_BAR; PG8_WAIT_L(0); PG8_MMA(0, 1, At, B1); PG8_BAR;
            PG8_LDA(At, 0, 1); PG8_STAGE(PG8_SA(0, 0), a2, voffA);
            PG8_BAR; PG8_WAIT_L(0); PG8_MMA(1, 0, At, B0); PG8_BAR; PG8_SCHED;
            PG8_STAGE(PG8_SB(0, 1), b2 + hstep, voffB);
            PG8_WAIT_V(6); PG8_BAR; PG8_MMA(1, 1, At, B1); PG8_BAR;
            PG8_LDB(B0, 1, 0); PG8_SCHED; PG8_LDA(At, 1, 0); PG8_STAGE(PG8_SA(0, 1), a2 + hstepA, voffA);
            PG8_WAIT_L(8); PG8_BAR; PG8_WAIT_L(0); PG8_MMA(0, 0, At, B0); PG8_BAR; PG8_SCHED;
            PG8_LDB(B1, 1, 1); PG8_STAGE(PG8_SB(1, 0), b3, voffB);
            PG8_BAR; PG8_WAIT_L(0); PG8_MMA(0, 1, At, B1); PG8_BAR;
            PG8_LDA(At, 1, 1); PG8_STAGE(PG8_SA(1, 0), a3, voffA);
            PG8_BAR; PG8_WAIT_L(0); PG8_MMA(1, 0, At, B0); PG8_BAR; PG8_SCHED;
            PG8_STAGE(PG8_SB(1, 1), b3 + hstep, voffB);
            PG8_WAIT_V(6); PG8_BAR; PG8_MMA(1, 1, At, B1); PG8_BAR;
            }
        }
        if constexpr (ALIGN_EPI) { if (wr == 0) PG8_BAR; }
        if constexpr (!Epi::AFTER_DRAIN) { E(acc, cur, wr, wc, fr, fq); S.done(cur); }
        if (!has_next) break;
#pragma unroll
        for (int a = 0; a < 2; ++a)
#pragma unroll
            for (int b = 0; b < 2; ++b)
#pragma unroll
                for (int m = 0; m < 4; ++m)
#pragma unroll
                    for (int n = 0; n < 2; ++n) acc[a][b][m][n] = (f32x4){0.f, 0.f, 0.f, 0.f};
        cur = nxt; cA = nA; cB = nB; ++ui;
        if constexpr (ALIGN_EPI) { if (wr == 1) PG8_BAR; }
    }
    PG8_WAIT_V(0);
    if constexpr (!ALIGN_EPI) { if (wr == 0) PG8_BAR; }
    PG8_BAR;
    if constexpr (Epi::AFTER_DRAIN) { E.fused(acc, cur, wr, wc, fr, fq, lds, wid, lane); S.done(cur); }
#undef PG8_SA
#undef PG8_AOFF
#undef PG8_SB
#undef PG8_STAGE
#undef PG8_LDA
#undef PG8_LDB
#undef PG8_MMA
#undef PG8_WAIT_V
#undef PG8_WAIT_L
#undef PG8_BAR
#undef PG8_SCHED
}
}

#include <hip/hip_bf16.h>
#include <cmath>
namespace attn_body {
using bf16=__hip_bfloat16;
using bf16x8=__attribute__((ext_vector_type(8)))short;
using s16x4=__attribute__((ext_vector_type(4)))short;
using f32x16=__attribute__((ext_vector_type(16)))float;
using u32x4=__attribute__((ext_vector_type(4)))unsigned;
using f32x4v=__attribute__((ext_vector_type(4)))float;
constexpr int BATCH=4,NHEAD=16,SEQ=8192,D=64,DM=NHEAD*D;
constexpr int NW=8,QBLK=32,QB=QBLK*NW,KVBLK=64,NQB=SEQ/QB;
constexpr int ATTN_PITCH=DM, ATTN_UNIT_ROWS=QB;
__device__ __forceinline__ int crow(int r,int hi){return (r&3)+8*(r>>2)+4*hi;}
#define SBAR() __builtin_amdgcn_sched_barrier(0)
__device__ __forceinline__ void cmask(f32x16&p0,f32x16&p1,int jb,int qrel,int hi){
  const float NEG=-INFINITY; int kb=64*jb+4*hi;
  #pragma unroll
  for(int r=0;r<16;++r){int kv=kb+(r&3)+8*(r>>2); if(kv>qrel)p0[r]=NEG; if(kv+32>qrel)p1[r]=NEG;}
}

constexpr int NSLOT=3, SLOTB=8192;
constexpr int LDS_K=0, LDS_V=NSLOT*SLOTB, LDS_WS=2*NSLOT*SLOTB, LDS_OST=LDS_WS+NW*64*4, LDS_F=86016, LDS_BYTES=LDS_F+SEQ*4;
constexpr float C2=0.125f*1.4426950408889634f;
__device__ __forceinline__ void glds16(const void*gsrc,unsigned lds_dst){unsigned keep;
  asm volatile("s_mov_b32 %0, m0\n\ts_mov_b32 m0, %2\n\ts_nop 0\n\tglobal_load_lds_dwordx4 %1, off\n\ts_mov_b32 m0, %0":"=&s"(keep):"v"(gsrc),"s"(lds_dst):"memory");}
__device__ __forceinline__ float max3f(float a,float b,float c){float r;asm("v_max3_f32 %0, %1, %2, %3":"=v"(r):"v"(a),"v"(b),"v"(c));return r;}
__device__ __forceinline__ float max2f(float a,float b){float r;asm("v_max_f32_e32 %0, %1, %2":"=v"(r):"v"(a),"v"(b));return r;}
__device__ __forceinline__ float fadd_s(float a,float b){float r;asm("v_add_f32_e32 %0, %1, %2":"=v"(r):"v"(a),"v"(b));return r;}
__device__ __forceinline__ float fsub_s(float a,float b){float r;asm("v_sub_f32_e32 %0, %1, %2":"=v"(r):"v"(a),"v"(b));return r;}
typedef float f32x2_t __attribute__((ext_vector_type(2))); typedef __bf16 bf16x2_t __attribute__((ext_vector_type(2)));
__device__ __forceinline__ unsigned cvtpk_s(float lo,float hi){f32x2_t v={lo,hi};bf16x2_t b=__builtin_convertvector(v,bf16x2_t);return __builtin_bit_cast(unsigned,b);}
#define WAIT_BAR(N) asm volatile("s_waitcnt vmcnt(" #N ") lgkmcnt(0)\n\ts_barrier":::"memory")

__device__ __forceinline__ void qkt(f32x16&p0,f32x16&p1,const char*Kslot,const bf16x8*qr,int r32,int hi){
  const char*kb=Kslot+hi*1024+r32*16;
  #pragma unroll
  for(int d0=0;d0<4;++d0){
    const bf16x8 b0=*reinterpret_cast<const bf16x8*>(kb+d0*2048);
    const bf16x8 b1=*reinterpret_cast<const bf16x8*>(kb+d0*2048+512);
    {p0=__builtin_amdgcn_mfma_f32_32x32x16_bf16(b0,qr[d0],p0,0,0,0);p1=__builtin_amdgcn_mfma_f32_32x32x16_bf16(b1,qr[d0],p1,0,0,0);}}
}
typedef __attribute__((address_space(3))) const char* lds_cptr;
typedef short v4i16_t __attribute__((ext_vector_type(4)));
__device__ __forceinline__ void kload8(bf16x8*kf,lds_cptr kp){
  kf[0]=*(const __attribute__((address_space(3))) bf16x8*)(kp);      kf[1]=*(const __attribute__((address_space(3))) bf16x8*)(kp+512);
  kf[2]=*(const __attribute__((address_space(3))) bf16x8*)(kp+2048); kf[3]=*(const __attribute__((address_space(3))) bf16x8*)(kp+2560);
  kf[4]=*(const __attribute__((address_space(3))) bf16x8*)(kp+4096); kf[5]=*(const __attribute__((address_space(3))) bf16x8*)(kp+4608);
  kf[6]=*(const __attribute__((address_space(3))) bf16x8*)(kp+6144); kf[7]=*(const __attribute__((address_space(3))) bf16x8*)(kp+6656);
}
__device__ __forceinline__ void kload2(bf16x8*kf,lds_cptr kp,int j){ kf[2*j]=*(const __attribute__((address_space(3))) bf16x8*)(kp+j*2048); kf[2*j+1]=*(const __attribute__((address_space(3))) bf16x8*)(kp+j*2048+512); }
__device__ __forceinline__ s16x4 vtr(lds_cptr p){ return __builtin_bit_cast(s16x4,__builtin_amdgcn_ds_read_tr16_b64_v4i16((__attribute__((address_space(3))) v4i16_t*)p)); }
__device__ __forceinline__ float rowmax(const f32x16&p0,const f32x16&p1){
  float a=max3f(p0[0],p0[1],p1[0]),b=max3f(p0[2],p0[3],p1[1]);a=max3f(a,p1[2],p1[3]);
  #pragma unroll
  for(int r=4;r<16;r+=4){a=max3f(a,p0[r],p0[r+1]);b=max3f(b,p0[r+2],p0[r+3]);a=max3f(a,p1[r],p1[r+1]);b=max3f(b,p1[r+2],p1[r+3]);}
  const float m=max2f(a,b);
  auto rr=__builtin_amdgcn_permlane32_swap(__float_as_uint(m),__float_as_uint(m),false,false);
  return max2f(__uint_as_float(rr[0]),__uint_as_float(rr[1]));
}
__device__ __forceinline__ void pv(f32x16*o,int vb,bf16x8 pa0,bf16x8 pa1,bf16x8 pa2,bf16x8 pa3){
  #pragma unroll
  for(int d0=0;d0<2;++d0){s16x4 lo[4],hi[4];
    #pragma unroll
    for(int ks=0;ks<4;++ks){
      asm volatile("ds_read_b64_tr_b16 %0,%1 offset:%c2":"=&v"(lo[ks]):"v"(vb),"i"(d0*4096+ks*1024):"memory");
      asm volatile("ds_read_b64_tr_b16 %0,%1 offset:%c2":"=&v"(hi[ks]):"v"(vb),"i"(d0*4096+ks*1024+512):"memory");}
    asm volatile("s_waitcnt lgkmcnt(0)":::"memory");SBAR();
    #define PK(k) (bf16x8){lo[k][0],lo[k][1],lo[k][2],lo[k][3],hi[k][0],hi[k][1],hi[k][2],hi[k][3]}
    o[d0]=__builtin_amdgcn_mfma_f32_32x32x16_bf16(pa0,PK(0),o[d0],0,0,0);
    o[d0]=__builtin_amdgcn_mfma_f32_32x32x16_bf16(pa1,PK(1),o[d0],0,0,0);
    o[d0]=__builtin_amdgcn_mfma_f32_32x32x16_bf16(pa2,PK(2),o[d0],0,0,0);
    o[d0]=__builtin_amdgcn_mfma_f32_32x32x16_bf16(pa3,PK(3),o[d0],0,0,0);
    #undef PK
  }
}

#ifndef ATTN_STORE16
#define ATTN_STORE16(p,v) (*(u32x4*)(p)=(v))
#endif
template<int THRL> __device__ __forceinline__ void attn_unit(int b,int h,int qb,int t0,const bf16*Q,const bf16*__restrict__ K,const bf16*__restrict__ V,bf16*O,const bf16*__restrict__ Gt,const float*__restrict__ Fg,char*shm){
  const int tid=threadIdx.x,lane=tid&63,r32=lane&31,hi=lane>>5; const int wid=__builtin_amdgcn_readfirstlane(tid>>6);
  const long rowbase=(long)b*SEQ; const int q0=qb*QB;
  const bf16*Qw=Q+(rowbase+q0+wid*QBLK)*DM+h*D;
  const bf16*Kh=K+(rowbase+(long)t0*KVBLK)*DM+h*D,*Vh=V+(rowbase+(long)t0*KVBLK)*DM+h*D;
  const unsigned lds0=(unsigned)(uintptr_t)shm;
  float*wsf=(float*)(shm+LDS_WS)+wid*64;
  const bf16*ksrc=Kh+(long)lane*DM+wid*8;
  const bf16*vsrc=Vh+(long)(16*(wid&3)+(lane>>2))*DM+(wid>>2)*32+(lane&3)*8;
  const unsigned kdst=lds0+LDS_K+wid*1024, vdst=lds0+LDS_V+wid*1024;
  #define DMA_K(t,slot) glds16(ksrc+(long)(t)*KVBLK*DM,(unsigned)__builtin_amdgcn_readfirstlane(kdst+(slot)))
  #define DMA_V(t,slot) glds16(vsrc+(long)(t)*KVBLK*DM,(unsigned)__builtin_amdgcn_readfirstlane(vdst+(slot)))
  const int vb0=(int)(lds0+LDS_V)+((lane>>4)&1)*32+(lane&3)*8+(4*hi+((lane&15)>>2))*64;
  const char*Kbase=shm+LDS_K; bf16x8 kf[8];
  const lds_cptr shm3=(lds_cptr)shm; const lds_cptr kp0=shm3+LDS_K+hi*1024+r32*16; const lds_cptr vp0=shm3+LDS_V+((lane>>4)&1)*32+(lane&3)*8+(4*hi+((lane&15)>>2))*64;
  const int NT=(q0+QB)/KVBLK-t0;
  typedef __attribute__((address_space(3))) float* lds_fptr; typedef __attribute__((address_space(3))) const f32x4v* lds_f4c;
  const float*Fsrc=Fg+((long)b*NHEAD+h)*SEQ; const lds_fptr Fl=(lds_fptr)(shm+LDS_F);
  const float fqv=Fsrc[q0+wid*QBLK+r32]; float fqm=fqv;
  #define FLD(X0,X1,tt) do{ const lds_fptr fp_=Fl+64*(tt)+4*hi; _Pragma("unroll") for(int a_=0;a_<4;++a_){ const f32x4v u0_=*(lds_f4c)(fp_+8*a_), u1_=*(lds_f4c)(fp_+32+8*a_); \
      X0[4*a_]=u0_[0];X0[4*a_+1]=u0_[1];X0[4*a_+2]=u0_[2];X0[4*a_+3]=u0_[3]; X1[4*a_]=u1_[0];X1[4*a_+1]=u1_[1];X1[4*a_+2]=u1_[2];X1[4*a_+3]=u1_[3]; } }while(0)
  typedef float f32x2p __attribute__((ext_vector_type(2)));
  #define SUBF(X0,X1) do{ const f32x2p fq2_={fqm,fqm}; _Pragma("unroll") for(int r=0;r<16;r+=2){ f32x2p a_={X0[r],X0[r+1]}, b_={X1[r],X1[r+1]}; a_=fq2_-a_; b_=fq2_-b_; X0[r]=a_[0];X0[r+1]=a_[1];X1[r]=b_[0];X1[r+1]=b_[1]; } asm volatile("":"+v"(X0),"+v"(X1)); }while(0)
  DMA_K(0,0);DMA_V(0,0);DMA_K(1,SLOTB);
  bf16x8 qr[4];
  #pragma unroll
  for(int d0=0;d0<4;++d0)qr[d0]=*reinterpret_cast<const bf16x8*>(&Qw[(long)r32*DM+d0*16+hi*8]);
  float mhat=0.f,l_reg=0.f;f32x16 o[2];o[0]=f32x16{};o[1]=f32x16{};
  const int qrel=wid*QBLK+r32;
  #define CMASK(P0,P1,t) do{int jb_=(t)-(NT-4); if(jb_>=0)cmask(P0,P1,jb_,qrel,hi);}while(0)
  bool resc=false;
  #define START(P0,P1) do{ const float rm=rowmax(P0,P1); resc=false; \
    { const float dl=max2f(rm,0.f); mhat=fadd_s(mhat,dl); \
      _Pragma("unroll") for(int r=0;r<16;++r){P0[r]=fsub_s(P0[r],dl);P1[r]=fsub_s(P1[r],dl);} \
      fqm=fqv-mhat; } \
    _Pragma("unroll") for(int r=0;r<16;++r)P0[r]=__builtin_amdgcn_exp2f(P0[r]); }while(0)
  #define RESC() do{ if(resc){ asm volatile("s_waitcnt lgkmcnt(0)":::"memory"); \
      _Pragma("unroll") for(int d_=0;d_<2;++d_) _Pragma("unroll") for(int r=0;r<16;++r)o[d_][r]*=wsf[crow(r,hi)]; } }while(0)
  f32x16 pA0,pA1,pB0,pB1;
  int sl_prev=0,sl_cur=0,sl_next=SLOTB;
  #define ROT() do{sl_prev=sl_cur;sl_cur=sl_next;sl_next=(sl_next==(NSLOT-1)*SLOTB)?0:sl_next+SLOTB;}while(0)
  DMA_K(2,2*SLOTB);
  { const float*Fs0=Fsrc+t0*KVBLK; const int n4=NT*(KVBLK/4); for(int i=tid;i<n4;i+=NW*64){ const f32x4v v=*(const f32x4v*)(Fs0+4*i); *(__attribute__((address_space(3))) f32x4v*)(Fl+4*i)=v; } }
  WAIT_BAR(3);
  FLD(pA0,pA1,0); SUBF(pA0,pA1); qkt(pA0,pA1,Kbase,qr,r32,hi);asm volatile("s_nop 15\n\ts_nop 7":"+v"(pA0),"+v"(pA1));CMASK(pA0,pA1,0);
  START(pA0,pA1);
  _Pragma("unroll") for(int r=0;r<16;++r)pA1[r]=__builtin_amdgcn_exp2f(pA1[r]);
  WAIT_BAR(0);
  DMA_K(3,0);DMA_V(1,SLOTB);
  ROT();
  kload8(kf,kp0+sl_cur);
  FLD(pB0,pB1,1);
  WAIT_BAR(2);
  s16x4 vlo[8],vhi[8]; u32x4 pw0,pw1,pw2,pw3;
  #define PKW(P,B) cvtpk_s(P[B],P[B+1])
  #define PAF(k) __builtin_bit_cast(bf16x8,pw##k)
  #define VFR(i) (bf16x8){vlo[i][0],vlo[i][1],vlo[i][2],vlo[i][3],vhi[i][0],vhi[i][1],vhi[i][2],vhi[i][3]}
  #define PIN(x) asm volatile("":"+v"(x))
  #define MX3(a,b,c) __builtin_fmaxf(__builtin_fmaxf((a),(b)),(c))
  #define GAPA(CD,MF,A0,A1,A2,A3,W0,W1,PW) do{ MF; PIN(CD); sacc+=A0; sacc+=A1; sacc+=A2; sacc+=A3; PIN(sacc); W0; W1; PIN(PW); SBAR(); }while(0)
  #define EX(v) __builtin_amdgcn_exp2f(v)
  #define GAPB(MF,X,B) do{ MF; X[B]=EX(X[B]); X[B+1]=EX(X[B+1]); X[B+2]=EX(X[B+2]); X[B+3]=EX(X[B+3]); PIN(X); SBAR(); }while(0)
  #define VRD(i) do{ vlo[i]=vtr(vp_+(((i)>>2)*4096+((i)&3)*1024)); vhi[i]=vtr(vp_+(((i)>>2)*4096+((i)&3)*1024+512)); }while(0)
  #define KRD(G,j) do{ if(G){ kload2(kf,kp0+sl_next,j); SBAR(); } }while(0)
  #define STEP(C0,C1,P0,P1,t,GK,GV,GL) do{ SBAR(); SUBF(C0,C1); SBAR(); \
    const lds_cptr vp_=vp0+sl_prev; \
    VRD(0); SBAR(); float sacc=(P0[0]+P0[1]); \
    GAPA(C0,C0=__builtin_amdgcn_mfma_f32_32x32x16_bf16(kf[0],qr[0],C0,0,0,0), P0[2],P0[3],P0[4],P0[5],     pw0[0]=PKW(P0,0), pw0[1]=PKW(P0,2), pw0); \
    VRD(4); SBAR(); GAPA(C1,C1=__builtin_amdgcn_mfma_f32_32x32x16_bf16(kf[1],qr[0],C1,0,0,0), P0[6],P0[7],P0[8],P0[9],     pw0[2]=PKW(P0,4), pw0[3]=PKW(P0,6), pw0); \
    VRD(1); SBAR(); GAPA(C0,C0=__builtin_amdgcn_mfma_f32_32x32x16_bf16(kf[2],qr[1],C0,0,0,0),   P0[10],P0[11],P0[12],P0[13], pw1[0]=PKW(P0,8), pw1[1]=PKW(P0,10), pw1); \
    VRD(5); SBAR(); GAPA(C1,C1=__builtin_amdgcn_mfma_f32_32x32x16_bf16(kf[3],qr[1],C1,0,0,0),   P0[14],P0[15],P1[0],P1[1],   pw1[2]=PKW(P0,12),pw1[3]=PKW(P0,14), pw1); \
    VRD(2); SBAR(); GAPA(C0,C0=__builtin_amdgcn_mfma_f32_32x32x16_bf16(kf[4],qr[2],C0,0,0,0),   P1[2],P1[3],P1[4],P1[5],     pw2[0]=PKW(P1,0), pw2[1]=PKW(P1,2), pw2); \
    VRD(6); SBAR(); GAPA(C1,C1=__builtin_amdgcn_mfma_f32_32x32x16_bf16(kf[5],qr[2],C1,0,0,0),   P1[6],P1[7],P1[8],P1[9],     pw2[2]=PKW(P1,4), pw2[3]=PKW(P1,6), pw2); \
    VRD(3); SBAR(); GAPA(C0,C0=__builtin_amdgcn_mfma_f32_32x32x16_bf16(kf[6],qr[3],C0,0,0,0),   P1[10],P1[11],P1[12],P1[13], pw3[0]=PKW(P1,8), pw3[1]=PKW(P1,10), pw3); \
    VRD(7); SBAR(); GAPA(C1,C1=__builtin_amdgcn_mfma_f32_32x32x16_bf16(kf[7],qr[3],C1,0,0,0),   P1[14],P1[15],0.f,0.f,       pw3[2]=PKW(P1,12),pw3[3]=PKW(P1,14), pw3); \
    l_reg+=sacc; if(GL){ FLD(P0,P1,(t)+1); } \
    if(GK){DMA_K((t)+3,sl_cur);} if(GV){DMA_V((t)+1,sl_next);} \
    CMASK(C0,C1,t); \
    { float a=MX3(C0[0],C0[1],C1[0]),b=MX3(C0[2],C0[3],C1[1]); a=MX3(a,C1[2],C1[3]); \
      _Pragma("unroll") for(int r=4;r<16;r+=4){a=MX3(a,C0[r],C0[r+1]);b=MX3(b,C0[r+2],C0[r+3]);a=MX3(a,C1[r],C1[r+1]);b=MX3(b,C1[r+2],C1[r+3]);} \
      float rm=__builtin_fmaxf(a,b); { auto rr=__builtin_amdgcn_permlane32_swap(__float_as_uint(rm),__float_as_uint(rm),false,false); rm=__builtin_fmaxf(__uint_as_float(rr[0]),__uint_as_float(rr[1])); } \
      resc=false; \
      if(__builtin_expect(__any(rm>(float)THRL),0)){ const float dl=__builtin_fmaxf(rm,0.f); mhat+=dl; \
        _Pragma("unroll") for(int r=0;r<16;++r){C0[r]-=dl;C1[r]-=dl;} \
        fqm=fqv-mhat; \
        const float f=__builtin_amdgcn_exp2f(-dl); l_reg*=f; if(hi==0)wsf[r32]=f; resc=true; } } \
    SBAR(); \
    GAPB(o[0]=__builtin_amdgcn_mfma_f32_32x32x16_bf16(PAF(0),VFR(0),o[0],0,0,0), C0,0); \
    GAPB(o[1]=__builtin_amdgcn_mfma_f32_32x32x16_bf16(PAF(0),VFR(4),o[1],0,0,0), C0,4); \
    KRD(GL,0); GAPB(o[0]=__builtin_amdgcn_mfma_f32_32x32x16_bf16(PAF(1),VFR(1),o[0],0,0,0), C0,8); \
    KRD(GL,1); GAPB(o[1]=__builtin_amdgcn_mfma_f32_32x32x16_bf16(PAF(1),VFR(5),o[1],0,0,0), C0,12); \
    KRD(GL,2); GAPB(o[0]=__builtin_amdgcn_mfma_f32_32x32x16_bf16(PAF(2),VFR(2),o[0],0,0,0), C1,0); \
    KRD(GL,3); GAPB(o[1]=__builtin_amdgcn_mfma_f32_32x32x16_bf16(PAF(2),VFR(6),o[1],0,0,0), C1,4); \
    GAPB(o[0]=__builtin_amdgcn_mfma_f32_32x32x16_bf16(PAF(3),VFR(3),o[0],0,0,0), C1,8); \
    GAPB(o[1]=__builtin_amdgcn_mfma_f32_32x32x16_bf16(PAF(3),VFR(7),o[1],0,0,0), C1,12); \
    }while(0)
  int t=1;
  #undef CMASK
  #define CMASK(P0,P1,t) do{}while(0)
  for(;t+5<NT;t+=2){
    STEP(pB0,pB1,pA0,pA1,t,true,true,true);     WAIT_BAR(2); RESC(); ROT();
    STEP(pA0,pA1,pB0,pB1,t+1,true,true,true);   WAIT_BAR(2); RESC(); ROT();
  }
  #undef CMASK
  #define CMASK(P0,P1,t) do{int jb_=(t)-(NT-4); if(jb_>=0)cmask(P0,P1,jb_,qrel,hi);}while(0)
  #define ENDW(tt) do{ if((tt)+3<NT){WAIT_BAR(2);} else if((tt)+2<NT){WAIT_BAR(1);} else {WAIT_BAR(0);} }while(0)
  for(;t+1<NT;t+=2){
    STEP(pB0,pB1,pA0,pA1,t,(t+3<NT),(t+1<NT),(t+1<NT));       ENDW(t);   RESC(); ROT();
    STEP(pA0,pA1,pB0,pB1,t+1,(t+4<NT),(t+2<NT),(t+2<NT));     ENDW(t+1); RESC(); ROT();
  }
  STEP(pB0,pB1,pA0,pA1,NT-1,false,false,false); RESC();
  { float sacc=pB0[0]+pB0[1]; _Pragma("unroll") for(int r=2;r<16;++r)sacc+=pB0[r]; _Pragma("unroll") for(int r=0;r<16;++r)sacc+=pB1[r]; l_reg+=sacc;
    pw0=(u32x4){PKW(pB0,0),PKW(pB0,2),PKW(pB0,4),PKW(pB0,6)};pw1=(u32x4){PKW(pB0,8),PKW(pB0,10),PKW(pB0,12),PKW(pB0,14)};pw2=(u32x4){PKW(pB1,0),PKW(pB1,2),PKW(pB1,4),PKW(pB1,6)};pw3=(u32x4){PKW(pB1,8),PKW(pB1,10),PKW(pB1,12),PKW(pB1,14)};
    SBAR(); pv(o,vb0+sl_cur,PAF(0),PAF(1),PAF(2),PAF(3)); }
  #undef PKW
  #undef PAF
  #undef VFR
  #undef PIN
  #undef MX3
  #undef GAPA
  #undef GAPB
  #undef EX
  #undef VRD
  #undef KRD
  #undef STEP
  #undef ENDW
  {auto rr=__builtin_amdgcn_permlane32_swap(__float_as_uint(l_reg),__float_as_uint(l_reg),false,false);l_reg=__uint_as_float(rr[0])+__uint_as_float(rr[1]);}
  if(hi==0)wsf[32+r32]=l_reg;asm volatile("s_waitcnt lgkmcnt(0)":::"memory");
  float rli[16];
  #pragma unroll
  for(int r=0;r<16;++r)rli[r]=__builtin_amdgcn_rcpf(wsf[32+crow(r,hi)]);
  bf16*Ow=O+(rowbase+q0+wid*QBLK)*DM+h*D; const bf16*Gw=Gt+(rowbase+q0+wid*QBLK)*DM+h*D;
  { bf16*stg=(bf16*)(shm+LDS_OST)+wid*2048;
    #pragma unroll
    for(int r=0;r<16;++r){const int orow=crow(r,hi);
      #pragma unroll
      for(int d0=0;d0<2;++d0)stg[orow*64+d0*32+r32]=__float2bfloat16(o[d0][r]*rli[r]);}
    asm volatile("s_waitcnt lgkmcnt(0)":::"memory");
    #pragma unroll
    for(int i=0;i<4;++i){const int row=i*8+(lane>>3),ch=lane&7; u32x4 v=*(const u32x4*)(stg+row*64+ch*8); const u32x4 gv=*(const u32x4*)(Gw+(long)row*DM+ch*8);
      _Pragma("unroll") for(int e=0;e<4;++e){ const float a0=__uint_as_float(v[e]<<16),a1=__uint_as_float(v[e]&0xffff0000u),g0=__uint_as_float(gv[e]<<16),g1=__uint_as_float(gv[e]&0xffff0000u); v[e]=cvtpk_s(a0*g0,a1*g1); }
      ATTN_STORE16(Ow+(long)row*DM+ch*8,v);} }
  asm volatile("s_waitcnt lgkmcnt(0)\n\ts_barrier":::"memory");
  #undef DMA_K
  #undef FLD
  #undef SUBF
  #undef DMA_V
  #undef CMASK
  #undef START
  #undef RESC
  #undef ROT
}
constexpr int ATTN_LDS_BYTES=LDS_BYTES;
constexpr long K_OFF=-67108864L, V_OFF=-33554432L, G_OFF=33554432L, O_OFF=-101711872L;
struct AttnTensors { bf16* Q; const float* F; const int* T0; };
struct AttnUnit { int bh; int qb; int t0; };
struct StaticOrder {
  const int* lst; int n;
  __device__ __forceinline__ explicit StaticOrder(const int* l,int cnt):lst(l),n(cnt){}
  __device__ __forceinline__ bool next(int i,AttnUnit&u)const{ if(i>=n)return false; const int w=__builtin_amdgcn_readfirstlane(lst[i]); const int un=w&0xffff; u.bh=un>>5; u.qb=un&31; u.t0=w>>16; return true; }
  __device__ __forceinline__ void a_ready(const AttnUnit&)const{}
  __device__ __forceinline__ void done(const AttnUnit&)const{}
};
template<class Sched,int THRL=8> __device__ __forceinline__ void attn_phase(char*lds,const AttnTensors&T,const Sched&S){
  AttnUnit u;
  for(int i=0;S.next(i,u);++i){ S.a_ready(u); attn_unit<THRL>(u.bh/NHEAD,u.bh%NHEAD,u.qb,u.t0,T.Q,T.Q+K_OFF,T.Q+V_OFF,T.Q+O_OFF,T.Q+G_OFF,T.F,lds); S.done(u); }
}
#undef SBAR
#undef WAIT_BAR
}

namespace cg = cooperative_groups;
constexpr int NWAVES = 8;
constexpr int BATCH = 4, SEQ = 8192, D = 1024, M = BATCH * SEQ, DFF = 2816, SGW = 2048;
constexpr float EPS = 1e-6f;
constexpr int NSYNC = 1;
constexpr unsigned long long REPMASK = 0ull;
constexpr size_t MiB = 1u << 20;
constexpr size_t WS_MODP = 1 * MiB, WS_MOD = 4 * MiB, WS_T0 = 4 * MiB + 512 * 1024, WS_WSM = 5 * MiB;
constexpr size_t WS_WFI = 6 * MiB, WS_WFO = 15 * MiB, WS_WSI = 17 * MiB, WS_WSO = 25 * MiB, WS_WUP0 = 29 * MiB, WS_WUP1 = 40 * MiB, WS_WDN0 = 51 * MiB, WS_WDN1 = 57 * MiB;
constexpr size_t WS_HN = 66 * MiB, WS_X1 = 132 * MiB, WS_K = 132 * MiB, WS_V = 196 * MiB, WS_VS = 132 * MiB;
constexpr size_t WS_Q = 260 * MiB, WS_G = 324 * MiB, WS_ACT = 260 * MiB, WS_U = 260 * MiB;
constexpr size_t WS_LOGF = 436 * MiB, WS_F = 438 * MiB, WS_STATS = 440 * MiB, WS_END = 448 * MiB;
constexpr int RING_BYTES = 131072, LDS_BYTES = 147456, LDSCTL_OFF = 143360;
constexpr size_t WS_CTL = 0, CTL_ZERO_BYTES = 65536;
static_assert(attn_body::ATTN_LDS_BYTES <= RING_BYTES, "attention LDS");

#define GAS __attribute__((address_space(1)))
#define LAS __attribute__((address_space(3)))
typedef unsigned short bf16;
typedef unsigned v4u __attribute__((ext_vector_type(4)));
typedef unsigned v2u __attribute__((ext_vector_type(2)));
typedef float f32x4 __attribute__((ext_vector_type(4)));
typedef float f32x2 __attribute__((ext_vector_type(2)));
typedef short bf16x8 __attribute__((ext_vector_type(8)));
#define LDS_WAIT() asm volatile("s_waitcnt lgkmcnt(0)" ::: "memory")
__device__ __forceinline__ unsigned f2bf(float f) { unsigned u = __builtin_bit_cast(unsigned, f); return (u + 0x7fffu + ((u >> 16) & 1u)) >> 16; }
__device__ __forceinline__ unsigned pk2(float lo, float hi) { return f2bf(lo) | (f2bf(hi) << 16); }
__device__ __forceinline__ float bflo(unsigned w) { return __uint_as_float(w << 16); }
__device__ __forceinline__ float bfhi(unsigned w) { return __uint_as_float(w & 0xffff0000u); }
__device__ __forceinline__ float wave_sum(float v) {
#pragma unroll
    for (int o = 1; o < 64; o <<= 1) v += __shfl_xor(v, o);
    return v;
}
template <int MODE> __device__ __forceinline__ int phys_blk(int nb) {
    if (MODE == 1) { if (nb >= 128) return nb; const int pn = nb >> 3, r = nb & 7; return pn * 8 + (r & 1) * 4 + (r >> 1); }
    if (MODE == 2) { const int bj = nb / 88, q = nb % 88; return (q >> 2) * 8 + bj * 4 + (q & 3); }
    return nb;
}
template <int MODE> __device__ __forceinline__ void transpose_item(const float* W, int K, int N, bf16* WT, LAS float* scr, int item, int lane) {
    const int nblk = (N + 63) / 64, kb = item / nblk, nb = item % nblk, k0 = 64 * kb, n0 = 64 * nb; const int kr = lane >> 4, nc = 4 * (lane & 15); const bool ok = n0 + nc < N;
#pragma unroll 8
    for (int i = 0; i < 16; ++i) { const int kk = 4 * i + kr; f32x4 v = (f32x4){0.f, 0.f, 0.f, 0.f}; if (ok) v = *(const f32x4*)(W + (size_t)(k0 + kk) * N + n0 + nc);
        LAS float* d = scr + kk * 65 + nc; d[0] = v.x; d[1] = v.y; d[2] = v.z; d[3] = v.w; }
    LDS_WAIT(); asm volatile("" ::: "memory");
    const int c = lane & 7;
#pragma unroll
    for (int j = 0; j < 8; ++j) { const int n = (lane >> 3) + 8 * j; const int pb = phys_blk<MODE>(2 * nb + (n >> 5)); const LAS float* s = scr + (8 * c) * 65 + n;
        v4u o; o.x = pk2(s[0 * 65], s[1 * 65]); o.y = pk2(s[2 * 65], s[3 * 65]); o.z = pk2(s[4 * 65], s[5 * 65]); o.w = pk2(s[6 * 65], s[7 * 65]);
        *(GAS v4u*)(WT + (size_t)(pb * 32 + (n & 31)) * K + k0 + 8 * c) = o; }
    LDS_WAIT(); asm volatile("" ::: "memory");
}
__device__ __forceinline__ void norm_row_bf16(const unsigned short* xrow, const float* g, const float* sh, const float* sc, bf16* orow, int lane) {
    const v4u a = *(const GAS v4u*)(xrow + 8 * lane), b = *(const GAS v4u*)(xrow + 512 + 8 * lane); float v[16]; float s = 0.f;
#pragma unroll
    for (int i = 0; i < 4; ++i) { v[2 * i] = pg8::h_lo(a[i]); v[2 * i + 1] = pg8::h_hi(a[i]); v[8 + 2 * i] = pg8::h_lo(b[i]); v[8 + 2 * i + 1] = pg8::h_hi(b[i]); }
#pragma unroll
    for (int i = 0; i < 16; ++i) s += v[i] * v[i];
    const float rstd = 1.0f / sqrtf(wave_sum(s) * (1.f / D) + EPS);
#pragma unroll
    for (int h = 0; h < 2; ++h) { const int c = 512 * h + 8 * lane; v4u w;
#pragma unroll
        for (int q = 0; q < 2; ++q) { const f32x4 gg = *(const f32x4*)(g + c + 4 * q), s1 = *(const f32x4*)(sc + c + 4 * q), s0 = *(const f32x4*)(sh + c + 4 * q);
            const f32x4 x4 = {v[8 * h + 4 * q], v[8 * h + 4 * q + 1], v[8 * h + 4 * q + 2], v[8 * h + 4 * q + 3]}; const f32x4 y = x4 * rstd * gg * (s1 + 1.0f) + s0;
            w[2 * q] = pk2(y.x, y.y); w[2 * q + 1] = pk2(y.z, y.w); }
        *(GAS v4u*)(orow + c) = w; }
}
#define XB_TMO      128
#define XB_XCNT(j)  (256  + 64 * (j))
#define XB_XSUB(j)  (1280 + 64 * (j))
#define XB_XGEN(j)  (2304 + 64 * (j))
#define XB_TOP      3328
#define XB_TOPGEN   3392
#define XCD_BAR_WORDS 3456
#define XB_SPIN_CAP (1u << 18)

__device__ __forceinline__ unsigned xb_ld(unsigned* p)              { return __hip_atomic_load(p, __ATOMIC_RELAXED, __HIP_MEMORY_SCOPE_AGENT); }
__device__ __forceinline__ unsigned xb_add(unsigned* p, unsigned v) { return __hip_atomic_fetch_add(p, v, __ATOMIC_RELAXED, __HIP_MEMORY_SCOPE_AGENT); }
__device__ __forceinline__ unsigned xb_xcc_id() { return (unsigned)__builtin_amdgcn_s_getreg((3 << 11) | 20) & 0xFu; }
#define XB_SPIN(cond, bar) do { unsigned _sp = 0; while (cond) { __builtin_amdgcn_s_sleep(1); \
    if ((++_sp & 255u) == 0u) { if (xb_ld(&(bar)[XB_TMO])) break; if (_sp > XB_SPIN_CAP) { atomicAdd(&(bar)[XB_TMO], 1u); break; } } } } while (0)

struct XcdBarrier {
    unsigned* bar; unsigned x;
    volatile LAS unsigned* st;
};

__device__ __forceinline__ XcdBarrier xcd_barrier_post(unsigned* bar, volatile LAS unsigned* st) {
    XcdBarrier b; b.bar = bar; b.x = xb_xcc_id(); b.st = st;
    if (threadIdx.x == 0) (void)xb_add(&bar[XB_XCNT(b.x)], 1u);
    return b;
}
__device__ __forceinline__ void xcd_barrier_complete(unsigned* bar, unsigned x, unsigned& nloc, unsigned& nx) {
    const unsigned G = gridDim.x * gridDim.y * gridDim.z;
    unsigned sum, cnt, mine, sp = 0u;
    for (;;) {
        sum = 0u; cnt = 0u; mine = 0u;
#pragma unroll
        for (unsigned j = 0; j < 16; ++j) { const unsigned c = xb_ld(&bar[XB_XCNT(j)]); sum += c; cnt += (c > 0u) ? 1u : 0u; mine = (j == x) ? c : mine; }
        if (sum == G) break;
        __builtin_amdgcn_s_sleep(1);
        if ((++sp & 255u) == 0u) { if (xb_ld(&bar[XB_TMO])) break; if (sp > XB_SPIN_CAP) { atomicAdd(&bar[XB_TMO], 1u); break; } }
    }
    nloc = mine > 0u ? mine : 1u; nx = cnt > 0u ? cnt : 1u;
}

__device__ __forceinline__ void xcd_barrier(const XcdBarrier& b) {
    asm volatile("s_waitcnt vmcnt(0)" ::: "memory");
    __syncthreads();
    if (threadIdx.x == 0) {
        unsigned* bar = b.bar;
        __builtin_amdgcn_s_waitcnt(0);
        unsigned nloc = b.st[0], nx = b.st[1];
        if (nloc == 0u) { xcd_barrier_complete(bar, b.x, nloc, nx); b.st[0] = nloc; b.st[1] = nx; }
        const unsigned old = xb_add(&bar[XB_XSUB(b.x)], 1u);
        const unsigned gen = old / nloc;
        if (old + 1u == (gen + 1u) * nloc) {
            __builtin_amdgcn_fence(__ATOMIC_RELEASE, "agent");
            asm volatile("s_waitcnt vmcnt(0)" ::: "memory");
            const unsigned og = xb_add(&bar[XB_TOP], 1u);
            const unsigned tg = og / nx;
            if (og + 1u == (tg + 1u) * nx) xb_add(&bar[XB_TOPGEN], 1u);
            else XB_SPIN(xb_ld(&bar[XB_TOPGEN]) == tg, bar);
            __builtin_amdgcn_fence(__ATOMIC_ACQUIRE, "agent");
            xb_add(&bar[XB_XGEN(b.x)], 1u);
            asm volatile("s_waitcnt vmcnt(0)" ::: "memory");
        } else {
            XB_SPIN(xb_ld(&bar[XB_XGEN(b.x)]) == gen, bar);
            __builtin_amdgcn_fence(__ATOMIC_ACQUIRE, "agent");
            asm volatile("s_waitcnt vmcnt(0)" ::: "memory");
        }
    }
    __syncthreads();
}

struct Args { const float* in[23]; float* out; unsigned char* ws; int ph_lo, ph_hi; };
typedef __attribute__((address_space(4))) const unsigned char* kptr_t;
__device__ __forceinline__ kptr_t kargs() { kptr_t p = (kptr_t)__builtin_amdgcn_kernarg_segment_ptr(); asm volatile("" : "+s"(p)); return p; }
#define ARGP(off, T) (*(T const __attribute__((address_space(4)))*)(kargs() + (off)))

__global__ void __launch_bounds__(NWAVES * 64, 2) fwd_mega(Args args) {
    extern __shared__ __attribute__((aligned(16))) unsigned char lds[];
    cg::grid_group grid = cg::this_grid();
    LAS unsigned char* const ldsl = (LAS unsigned char*)lds;
    const int tid = threadIdx.x, lane = tid & 63, wave = __builtin_amdgcn_readfirstlane(tid >> 6);
    const int G = gridDim.x; const int bx = blockIdx.x; const int vcu = (G % 8 == 0) ? (bx % 8) * (G / 8) + bx / 8 : bx;
    const int gw = vcu * NWAVES + wave, NGW = G * NWAVES;
#define A_IN(i) ARGP(8 * (i), const float*)
#define ws ARGP(192, unsigned char*)
#define x_in A_IN(0)
#define out ARGP(184, float*)
#define MODP ((float*)(ws + WS_MODP))
#define MOD ((float*)(ws + WS_MOD))
#define T0 ((int*)(ws + WS_T0))
#define WSM ((bf16*)(ws + WS_WSM))
#define WFI ((bf16*)(ws + WS_WFI))
#define WFO ((bf16*)(ws + WS_WFO))
#define WSI ((bf16*)(ws + WS_WSI))
#define WSO ((bf16*)(ws + WS_WSO))
#define HN ((bf16*)(ws + WS_HN))
#define X1H ((unsigned short*)(ws + WS_X1))
#define X2H2 ((unsigned short*)(ws + WS_X1 + 64 * MiB))
#define X2H ((unsigned short*)out)
#define QB ((bf16*)(ws + WS_Q))
#define KB ((bf16*)(ws + WS_K))
#define VB ((bf16*)(ws + WS_V))
#define GB ((bf16*)(ws + WS_G))
#define ACT ((bf16*)(ws + WS_ACT))
#define UB ((bf16*)(ws + WS_U))
#define VS ((bf16*)(ws + WS_VS))
#define LOGF ((float*)(ws + WS_LOGF))
#define FB ((float*)(ws + WS_F))
#define STATS ((float*)(ws + WS_STATS))
    const int lo = ARGP(200, int), hi = ARGP(204, int);
    for (int u = tid; u < 64; u += NWAVES * 64) ((LAS unsigned*)(ldsl + LDSCTL_OFF))[u] = 0u;
    __syncthreads();
    XcdBarrier bar = xcd_barrier_post((unsigned*)(ws + WS_CTL), (volatile LAS unsigned*)(ldsl + LDSCTL_OFF) + 8);
    if (lo > 4096) grid.sync();
#define PHASE_BEGIN(k) if ((k) >= lo && (k) < hi) for (int rep_ = 0; rep_ <= (int)((REPMASK >> (k)) & 1ull); ++rep_) {
#define PHASE_END(k) if ((k) + 1 < hi) { for (int s_ = 0; s_ < NSYNC; ++s_) xcd_barrier(bar); } }
#define MODV(l, k) (MOD + (size_t)(l) * 4 * 6144 + (k) * 1024)

    constexpr int CV_FI = 16 * 65, CV_FO = 16 * 16, CV_SI = 16 * 64, CV_SO = 32 * 16, CV_UP = 16 * 88, CV_DN = 44 * 16;
    constexpr int CV_G2 = CV_FI, CV_G3 = CV_G2 + CV_FO + CV_UP + CV_DN, CV_END = CV_G3 + CV_SI + CV_SO + CV_UP + CV_DN;
#define CONVERT_ITEM(R, SCR) do { int r_ = (R); \
        if (r_ < CV_FI) { transpose_item<1>(A_IN(2), D, 4112, WFI, SCR, r_, lane); break; } r_ -= CV_FI; \
        if (r_ < CV_FO) { transpose_item<0>(A_IN(6), D, D, WFO, SCR, r_, lane); break; } r_ -= CV_FO; \
        if (r_ < CV_UP) { transpose_item<2>(A_IN(14), D, 5632, (bf16*)(ws + WS_WUP0), SCR, r_, lane); break; } r_ -= CV_UP; \
        if (r_ < CV_DN) { transpose_item<0>(A_IN(17), DFF, D, (bf16*)(ws + WS_WDN0), SCR, r_, lane); break; } r_ -= CV_DN; \
        if (r_ < CV_SI) { transpose_item<0>(A_IN(7), D, 4096, WSI, SCR, r_, lane); break; } r_ -= CV_SI; \
        if (r_ < CV_SO) { transpose_item<0>(A_IN(13), SGW, D, WSO, SCR, r_, lane); break; } r_ -= CV_SO; \
        if (r_ < CV_UP) { transpose_item<2>(A_IN(14) + (size_t)D * 5632, D, 5632, (bf16*)(ws + WS_WUP1), SCR, r_, lane); break; } r_ -= CV_UP; \
        transpose_item<0>(A_IN(17) + (size_t)DFF * D, DFF, D, (bf16*)(ws + WS_WDN1), SCR, r_, lane); } while (0)
    PHASE_BEGIN(0)
    {
        LAS float* scr = (LAS float*)(ldsl + wave * 16640);
        constexpr int I_MOD = 768;
        for (int it = gw; it < I_MOD + CV_FI; it += NGW) {
            int r = it;
            if (r >= I_MOD) { CONVERT_ITEM(r - I_MOD, scr); continue; }
            if (r < I_MOD) {
                const int l = r / 384, q = r % 384, nc = q >> 4, ks = q & 15, n0 = nc * 256 + 4 * lane, k0 = ks * 64;
                float ca[4];
#pragma unroll
                for (int b = 0; b < 4; ++b) { const float cv = A_IN(1)[b * D + k0 + lane]; ca[b] = cv / (1.0f + __expf(-cv)); }
                f32x4 a[4] = {(f32x4){0, 0, 0, 0}, (f32x4){0, 0, 0, 0}, (f32x4){0, 0, 0, 0}, (f32x4){0, 0, 0, 0}};
                const float* wp = A_IN(18) + ((size_t)l * D + k0) * 6144 + n0;
#pragma unroll 16
                for (int kk = 0; kk < 64; ++kk) { const f32x4 wv = *(const f32x4*)(wp + (size_t)kk * 6144);
#pragma unroll
                    for (int b = 0; b < 4; ++b) { const float cb = __builtin_bit_cast(float, __builtin_amdgcn_readlane(__builtin_bit_cast(int, ca[b]), kk)); a[b] += wv * cb; } }
#pragma unroll
                for (int b = 0; b < 4; ++b) *(f32x4*)(MODP + ((size_t)(ks * 2 + l) * 4 + b) * 6144 + n0) = a[b];
                continue;
            }
        }
        { v4u z = {0u, 0u, 0u, 0u}; GAS v4u* p = (GAS v4u*)(WFI + (size_t)4128 * D); const int n16 = 224 * D * 2 / 16; for (int i = gw * 64 + lane; i < n16; i += NGW * 64) p[i] = z; }
        for (int i = gw * 64 + lane; i < 8 * 128 * 128 / 2; i += NGW * 64) { const int e = 2 * i, s = e & 127, t = (e >> 7) & 127; const f32x2 w = *(const f32x2*)(A_IN(11) + e);
            const bool keep = (s >> 6) <= (t >> 6); ((GAS unsigned*)WSM)[i] = keep ? pk2(w.x, w.y) : 0u; }
    }
    PHASE_END(0)
    PHASE_BEGIN(2)
    {
        for (int i = bx * 512 + tid; i < 2 * 4 * 6144; i += G * 512) { const int l = i / (4 * 6144), n = i % 6144; float s = A_IN(19)[l * 6144 + n];
#pragma unroll
            for (int ks = 0; ks < 16; ++ks) s += MODP[(size_t)ks * 2 * 4 * 6144 + i];
            MOD[i] = s; }
        LAS float* mv = (LAS float*)ldsl;
        for (int i = tid; i < 4 * 512; i += 512) { const int b = i >> 9, c4 = (i & 511) * 4; f32x4 s = *(const f32x4*)(A_IN(19) + c4);
#pragma unroll
            for (int ks = 0; ks < 16; ++ks) s += *(const f32x4*)(MODP + ((size_t)(ks * 2) * 4 + b) * 6144 + c4);
            *(LAS f32x4*)(mv + b * 2048 + c4) = s; }
        constexpr int RSW = 2064;
        LAS unsigned char* wfb = ldsl + 32768;
        for (int i = tid; i < 2048; i += 512) { const int h = i >> 7, c = i & 127; *(LAS v4u*)(wfb + h * RSW + c * 16) = *(const v4u*)(WFI + (size_t)(4096 + h) * D + c * 8); }
        __syncthreads();
        const int fr = lane & 15, fq = lane >> 4;
        for (int m0 = gw; m0 < M; m0 += 16 * NGW) {
            for (int i = 0; i < 16; ++i) { int m = m0 + i * NGW; m = m < M ? m : M - 1; const int b = m >> 13;
                const GAS f32x4* xr = (const GAS f32x4*)(x_in + (size_t)m * D) + lane; f32x4 v[4]; float s = 0.f;
#pragma unroll
                for (int j = 0; j < 4; ++j) { v[j] = xr[64 * j]; s += (v[j].x * v[j].x + v[j].y * v[j].y) + (v[j].z * v[j].z + v[j].w * v[j].w); }
                const float rstd = 1.0f / sqrtf(wave_sum(s) * (1.f / D) + EPS);
                GAS v2u* o8 = (GAS v2u*)(HN + (size_t)m * D) + lane;
#pragma unroll
                for (int j = 0; j < 4; ++j) { const int c = 4 * lane + 256 * j; const f32x4 gg = *(const f32x4*)(A_IN(20) + c), s0 = *(LAS f32x4*)(mv + b * 2048 + c), s1 = *(LAS f32x4*)(mv + b * 2048 + 1024 + c);
                    const f32x4 y = v[j] * rstd * gg * (s1 + 1.0f) + s0; v2u w; w.x = pk2(y.x, y.y); w.y = pk2(y.z, y.w); o8[64 * j] = w; } }
            asm volatile("s_waitcnt vmcnt(0)" ::: "memory");
            int mr = m0 + fr * NGW; const bool mok = mr < M; mr = mok ? mr : M - 1;
            f32x4 acc = {0.f, 0.f, 0.f, 0.f}; const bf16* arow = HN + (size_t)mr * D + 8 * fq;
#pragma unroll 8
            for (int ks = 0; ks < 32; ++ks) { const bf16x8 af = *(const GAS bf16x8*)(arow + 32 * ks); const bf16x8 wf = *(const LAS bf16x8*)(wfb + fr * RSW + (32 * ks + 8 * fq) * 2);
                acc = __builtin_amdgcn_mfma_f32_16x16x32_bf16(wf, af, acc, 0, 0, 0); }
            const f32x4 bb = *(const f32x4*)(A_IN(3) + 4 * fq); const int srow = mr & 8191, b = mr >> 13;
            if (mok)
#pragma unroll
            for (int j = 0; j < 4; ++j) { const float x = acc[j] + bb[j]; const float lf = fminf(x, 0.f) - __logf(1.0f + __expf(-fabsf(x))); LOGF[((size_t)(b * 16 + 4 * fq + j) << 13) + srow] = lf; }
        }
        __syncthreads();
    }
    PHASE_END(2)
    PHASE_BEGIN(3)
    { pg8::Gemm g{HN, WFI, M, 4096, D}; pg8::StaticOrder S; S.init(M, 4096, G, bx);
      pg8::EpiFoxIn E{QB, KB, VB, GB, LOGF, A_IN(4), A_IN(5), A_IN(3)};
      pg8::gemm_phase<pg8::EpiFoxIn, pg8::StaticOrder, true, true>(ldsl, g, S, E);
 }
    PHASE_END(3)
    PHASE_BEGIN(4)
    { LAS float* scr = (LAS float*)(ldsl + wave * 16640);
      if (G > 64) { if (vcu >= 64) for (int it = CV_G2 + (vcu - 64) * NWAVES + wave; it < CV_G3; it += (G - 64) * NWAVES) CONVERT_ITEM(it, scr); }
      else for (int it = CV_G2 + gw; it < CV_G3; it += NGW) CONVERT_ITEM(it, scr); }
    __syncthreads();
    for (int bh = vcu; bh < 64; bh += G) {
        LAS float* Fl = (LAS float*)ldsl; LAS float* wt = (LAS float*)(ldsl + 32768);
        const float* src = LOGF + (size_t)bh * SEQ + tid * 16; f32x4 v[4];
#pragma unroll
        for (int j = 0; j < 4; ++j) v[j] = *(const f32x4*)(src + 4 * j);
        float p[16]; float run = 0.f;
#pragma unroll
        for (int j = 0; j < 4; ++j) { run += v[j].x; p[4 * j] = run; run += v[j].y; p[4 * j + 1] = run; run += v[j].z; p[4 * j + 2] = run; run += v[j].w; p[4 * j + 3] = run; }
        float inc = run;
#pragma unroll
        for (int o = 1; o < 64; o <<= 1) { const float t = __shfl_up(inc, o); if (lane >= o) inc += t; }
        if (lane == 63) wt[wave] = inc;
        __syncthreads();
        float offs = inc - run;
        for (int w = 0; w < wave; ++w) offs += wt[w];
#pragma unroll
        for (int j = 0; j < 4; ++j) { f32x4 o; o.x = (offs + p[4 * j]) * 1.4426950409f; o.y = (offs + p[4 * j + 1]) * 1.4426950409f; o.z = (offs + p[4 * j + 2]) * 1.4426950409f; o.w = (offs + p[4 * j + 3]) * 1.4426950409f;
            *(f32x4*)(FB + (size_t)bh * SEQ + tid * 16 + 4 * j) = o; *(LAS f32x4*)(Fl + tid * 16 + 4 * j) = o; }
        __syncthreads();
        if (tid < 32) {
            float gq = 0.f, gk = 0.f;
            for (int i = 0; i < 64; ++i) { gq = fmaxf(gq, fabsf(A_IN(4)[i])); gk = fmaxf(gk, fabsf(A_IN(5)[i])); }
            const float thr = 40.0f + 2.0f * 64.0f * 0.18033688f * gq * gk;
            const int qb = tid, q0 = 256 * qb; int t0 = 4 * qb; const float fq0 = Fl[q0];
            while (t0 > 0 && !(Fl[64 * t0 - 1] - fq0 > thr)) t0 -= 2;
            T0[bh * 32 + qb] = t0;
        }
        __syncthreads();
    }
    PHASE_END(4)
    PHASE_BEGIN(5)
    { static_assert((long)WS_K - (long)WS_Q == 2 * attn_body::K_OFF && (long)WS_V - (long)WS_Q == 2 * attn_body::V_OFF && (long)WS_G - (long)WS_Q == 2 * attn_body::G_OFF && (long)WS_HN - (long)WS_Q == 2 * attn_body::O_OFF, "attention operand offsets");
      const attn_body::AttnTensors AT{(attn_body::bf16*)QB, FB, T0};
      LAS int* cntw = (LAS int*)(ldsl + 120832); LAS int* tot = cntw + 512; LAS int* sorted = tot + 64; LAS int* mine = sorted + 2048;
      cntw[tid] = 0;
      __syncthreads();
      int key[4];
#pragma unroll
      for (int j = 0; j < 4; ++j) { const int un = 4 * tid + j; const int nt = 4 * (un & 31) + 4 - T0[un]; key[j] = 64 - (nt >> 1); atomicAdd((int*)(cntw + wave * 64 + key[j]), 1); }
      __syncthreads();
      if (tid < 64) { int run = 0; for (int w = 0; w < 8; ++w) { const int c = cntw[w * 64 + tid]; cntw[w * 64 + tid] = run; run += c; } tot[tid] = run; }
      __syncthreads();
      if (tid == 0) { int run = 0; for (int k = 0; k < 64; ++k) { const int c = tot[k]; tot[k] = run; run += c; } }
      __syncthreads();
      { int rank[4] = {0, 0, 0, 0}; const unsigned long long lt = (1ull << lane) - 1ull;
        for (int b = 0; b < 64; ++b) {
            const unsigned long long m0 = __ballot(key[0] == b), m1 = __ballot(key[1] == b), m2 = __ballot(key[2] == b), m3 = __ballot(key[3] == b);
            if ((m0 | m1 | m2 | m3) == 0ull) continue;
            const int lower = __popcll(m0 & lt) + __popcll(m1 & lt) + __popcll(m2 & lt) + __popcll(m3 & lt);
            int same = 0;
#pragma unroll
            for (int j = 0; j < 4; ++j) if (key[j] == b) { rank[j] = lower + same; ++same; }
        }
#pragma unroll
        for (int j = 0; j < 4; ++j) sorted[tot[key[j]] + cntw[wave * 64 + key[j]] + rank[j]] = 4 * tid + j; }
      __syncthreads();
      const int nrounds = (2048 + G - 1) / G; int nmine = 0;
      for (int r = 0; r < nrounds; ++r) { const int j = r * G + ((r & 1) ? (G - 1 - vcu) : vcu); if (j < 2048) { if (tid == 0) { const int un = sorted[j]; mine[nmine] = un | (T0[un] << 16); } ++nmine; } }
      __syncthreads();
      const attn_body::StaticOrder S((const int*)mine, nmine);
      attn_body::attn_phase<attn_body::StaticOrder>((char*)lds, AT, S); }
    PHASE_END(5)
    PHASE_BEGIN(6)
    { pg8::Gemm g{HN, WFO, M, D, D}; pg8::StaticOrder S; S.init(M, D, G, bx);
      pg8::EpiRes<true> E{x_in, X1H, MODV(0, 2)};
      pg8::gemm_phase<pg8::EpiRes<true>, pg8::StaticOrder, true, true>(ldsl, g, S, E); }
    PHASE_END(6)
#define FFN_BLOCK(l, XIN, XOUT, PB) \
    PHASE_BEGIN(PB) \
    for (int m = gw; m < M; m += NGW) { const int b = m >> 13; norm_row_bf16((XIN) + (size_t)m * D, A_IN(21) + (l) * D, MODV(l, 3) + b * 6144, MODV(l, 4) + b * 6144, HN + (size_t)m * D, lane); } \
    PHASE_END(PB) \
    PHASE_BEGIN((PB) + 1) \
    { pg8::Gemm g{HN - 2 * D, (const bf16*)(ws + ((l) ? WS_WUP1 : WS_WUP0)), 136 * 256, 5632, D}; pg8::StaticOrder S; S.init(136 * 256, 5632, G, bx); \
      pg8::EpiFfnUp E{ACT, A_IN(15) + (size_t)(l) * 3 * 5632, A_IN(16) + (size_t)(l) * 5632}; \
      pg8::gemm_phase<pg8::EpiFfnUp, pg8::StaticOrder, true, true, true>(ldsl, g, S, E); \
      if ((l) == 0) { const int rem = (136 * 22) % G; LAS float* scr = (LAS float*)(ldsl + wave * 16640);     \
        if (rem != 0) { if (bx >= rem) for (int it = CV_G3 + (bx - rem) * NWAVES + wave; it < CV_END; it += (G - rem) * NWAVES) CONVERT_ITEM(it, scr); } \
        else for (int it = CV_G3 + gw; it < CV_END; it += NGW) CONVERT_ITEM(it, scr); } } \
    PHASE_END((PB) + 1) \
    PHASE_BEGIN((PB) + 2) \
    { pg8::Gemm g{ACT, (const bf16*)(ws + ((l) ? WS_WDN1 : WS_WDN0)), M, D, DFF}; pg8::StaticOrder S; S.init(M, D, G, bx); \
      pg8::EpiRes<false> E{(XIN), (XOUT), MODV(l, 5)}; \
      pg8::gemm_phase<pg8::EpiRes<false>, pg8::StaticOrder, true, true>(ldsl, g, S, E); } \
    PHASE_END((PB) + 2)
    FFN_BLOCK(0, X1H, X2H, 7)
    PHASE_BEGIN(10)
    for (int m = gw; m < M; m += NGW) { const int b = m >> 13; norm_row_bf16(X2H + (size_t)m * D, A_IN(20) + D, MODV(1, 0) + b * 6144, MODV(1, 1) + b * 6144, HN + (size_t)m * D, lane); }
    PHASE_END(10)
    PHASE_BEGIN(11)
    { pg8::Gemm g{HN, WSI, M, 4096, D}; pg8::StaticOrder S; S.init(M, 4096, G, bx);
      pg8::EpiSguIn E{UB, VS, A_IN(8), STATS};
      pg8::gemm_phase<pg8::EpiSguIn, pg8::StaticOrder, true, true>(ldsl, g, S, E); }
    PHASE_END(11)
    PHASE_BEGIN(12)
    {
        constexpr int RS = 272, OFF_B = 128 * RS, OFF_ST = OFF_B + 256 * RS;
        const int g = bx & 7;
        for (int i = tid; i < 128 * 16; i += 512) { const int r = i >> 4, c = i & 15; *(LAS v4u*)(ldsl + r * RS + c * 16) = *(const v4u*)(WSM + ((size_t)g * 128 + r) * 128 + c * 8); }
        const int cc = tid & 31; float gn[8], bs[8];
#pragma unroll
        for (int e = 0; e < 8; ++e) { gn[e] = A_IN(9)[g * 256 + 8 * cc + e]; bs[e] = A_IN(10)[g * 256 + 8 * cc + e]; }
        const int fr = lane & 15, fq = lane >> 4, wm = wave >> 2, wn = wave & 3;
        LAS f32x2* ST = (LAS f32x2*)(ldsl + OFF_ST);
        v4u va[4], vb[4]; f32x4 sq[4];
#define MIX_LOAD(IDX) do { const size_t rb_ = (size_t)((IDX) >> 3) * 128; \
            _Pragma("unroll") for (int it = 0; it < 4; ++it) { const int sp = (it * 512 + tid) >> 5; const bf16* vp = VS + (rb_ + 2 * sp) * SGW + g * 256 + 8 * cc; va[it] = *(const v4u*)vp; vb[it] = *(const v4u*)(vp + SGW); } \
            { const float* sp_ = STATS + (rb_ + (tid >> 2)) * 64 + (tid & 3) * 16; _Pragma("unroll") for (int j = 0; j < 4; ++j) sq[j] = *(const f32x4*)(sp_ + 4 * j); } } while (0)
        float bsv4[4];
#pragma unroll
        for (int m = 0; m < 4; ++m) bsv4[m] = A_IN(12)[g * 128 + 64 * wm + 16 * m + fr];
        int idx = bx; if (idx < 2048) MIX_LOAD(idx);
        for (; idx < 2048; idx += G) {
            const int bn = idx >> 3; const size_t rowbase = (size_t)bn * 128;
            { float s1 = 0.f, s2 = 0.f;
#pragma unroll
              for (int j = 0; j < 4; ++j) { s1 += sq[j].x + sq[j].z; s2 += sq[j].y + sq[j].w; }
              s1 += __shfl_xor(s1, 1); s1 += __shfl_xor(s1, 2); s2 += __shfl_xor(s2, 1); s2 += __shfl_xor(s2, 2);
              if ((tid & 3) == 0) { const float mu = s1 * (1.f / SGW); const float var = fmaxf(s2 * (1.f / SGW) - mu * mu, 0.f); ST[tid >> 2] = (f32x2){mu, 1.0f / sqrtf(var + EPS)}; } }
            __syncthreads();
#pragma unroll
            for (int it = 0; it < 4; ++it) { const int sp = (it * 512 + tid) >> 5; const v4u a = va[it], b = vb[it]; const f32x2 st0 = ST[2 * sp], st1 = ST[2 * sp + 1];
#pragma unroll
                for (int e = 0; e < 8; ++e) { const unsigned wa = a[e >> 1], wb = b[e >> 1]; const float x0 = (e & 1) ? bfhi(wa) : bflo(wa), x1 = (e & 1) ? bfhi(wb) : bflo(wb);
                    const float y0 = (x0 - st0.x) * st0.y * gn[e] + bs[e], y1 = (x1 - st1.x) * st1.y * gn[e] + bs[e];
                    *(LAS unsigned*)(ldsl + OFF_B + (8 * cc + e) * RS + ((((sp >> 2) ^ (cc & 7)) << 2) | (sp & 3)) * 4) = pk2(y0, y1); } }
            __syncthreads();
            { const int nidx = idx + G; if (nidx < 2048) MIX_LOAD(nidx); }
            f32x4 acc[4][4];
#pragma unroll
            for (int m = 0; m < 4; ++m)
#pragma unroll
                for (int n = 0; n < 4; ++n) acc[m][n] = (f32x4){0.f, 0.f, 0.f, 0.f};
#pragma unroll
            for (int kk = 0; kk < 4; ++kk) {
                if (wm == 0 && kk >= 2) continue;
                bf16x8 Af[4], Bf[4];
#pragma unroll
                for (int m = 0; m < 4; ++m) Af[m] = *(const LAS bf16x8*)(ldsl + (64 * wm + 16 * m + fr) * RS + (32 * kk + 8 * fq) * 2);
#pragma unroll
                for (int n = 0; n < 4; ++n) { const int crow = 64 * wn + 32 * (n >> 1) + 8 * (fr >> 2) + 4 * (n & 1) + (fr & 3); Bf[n] = *(const LAS bf16x8*)(ldsl + OFF_B + crow * RS + (((4 * kk + fq) ^ ((crow >> 3) & 7)) << 4)); }
#pragma unroll
                for (int m = 0; m < 4; ++m)
#pragma unroll
                    for (int n = 0; n < 4; ++n) acc[m][n] = __builtin_amdgcn_mfma_f32_16x16x32_bf16(Bf[n], Af[m], acc[m][n], 0, 0, 0);
            }
            v4u uu[4][2];
#pragma unroll
            for (int m = 0; m < 4; ++m)
#pragma unroll
                for (int p = 0; p < 2; ++p) uu[m][p] = *(const v4u*)(UB + (rowbase + 64 * wm + 16 * m + fr) * SGW + g * 256 + 64 * wn + 32 * p + 8 * fq);
#pragma unroll
            for (int m = 0; m < 4; ++m) { const int t = 64 * wm + 16 * m + fr; const float bsv = bsv4[m];
#pragma unroll
                for (int p = 0; p < 2; ++p) { bf16* up = UB + (rowbase + t) * SGW + g * 256 + 64 * wn + 32 * p + 8 * fq; v4u o;
#pragma unroll
                    for (int e = 0; e < 4; ++e) { const f32x4 lo4 = acc[m][2 * p], hi4 = acc[m][2 * p + 1];
                        const float m0 = ((e < 2) ? lo4[2 * e] : hi4[2 * e - 4]) + bsv, m1 = ((e < 2) ? lo4[2 * e + 1] : hi4[2 * e - 3]) + bsv;
                        o[e] = pk2(pg8::gelu_tanh(bflo(uu[m][p][e])) * m0, pg8::gelu_tanh(bfhi(uu[m][p][e])) * m1); }
                    if (rep_ == (int)((REPMASK >> 12) & 1ull)) *(v4u*)up = o; } }
            __syncthreads();
        }
#undef MIX_LOAD
    }
    PHASE_END(12)
    PHASE_BEGIN(13)
    { pg8::Gemm g{UB, WSO, M, D, SGW}; pg8::StaticOrder S; S.init(M, D, G, bx);
      pg8::EpiRes<false> E{X2H, X1H, MODV(1, 2)};
      pg8::gemm_phase<pg8::EpiRes<false>, pg8::StaticOrder, true, true>(ldsl, g, S, E); }
    PHASE_END(13)
    FFN_BLOCK(1, X1H, X2H2, 14)
    PHASE_BEGIN(17)
    for (int m = gw; m < M; m += NGW) { const unsigned short* xrow = X2H2 + (size_t)m * D; const v4u a = *(const GAS v4u*)(xrow + 8 * lane), b = *(const GAS v4u*)(xrow + 512 + 8 * lane); float v[16]; float s = 0.f;
#pragma unroll
        for (int i = 0; i < 4; ++i) { v[2 * i] = pg8::h_lo(a[i]); v[2 * i + 1] = pg8::h_hi(a[i]); v[8 + 2 * i] = pg8::h_lo(b[i]); v[8 + 2 * i + 1] = pg8::h_hi(b[i]); }
#pragma unroll
        for (int i = 0; i < 16; ++i) s += v[i] * v[i];
        const float rstd = 1.0f / sqrtf(wave_sum(s) * (1.f / D) + EPS);
#pragma unroll
        for (int h = 0; h < 2; ++h)
#pragma unroll
            for (int q = 0; q < 2; ++q) { const int c = 512 * h + 8 * lane + 4 * q; const f32x4 gg = *(const f32x4*)(A_IN(22) + c);
                const f32x4 x4 = {v[8 * h + 4 * q], v[8 * h + 4 * q + 1], v[8 * h + 4 * q + 2], v[8 * h + 4 * q + 3]}; *(GAS f32x4*)(out + (size_t)m * D + c) = x4 * rstd * gg; } }
    PHASE_END(17)
}

#undef ws
#undef out
#undef x_in
#undef T0
#undef A_IN
extern "C" void kernel_launch(void* const* d_in, const int* in_sizes, int n_in, void* d_out, int out_size, void* d_ws, size_t ws_size, hipStream_t stream) {
    static int grid = 0;
    if (grid == 0) {
        if (n_in != 23 || in_sizes[0] != M * D || out_size != M * D || ws_size < WS_END) { fprintf(stderr, "kernel_launch: unexpected shapes/workspace (n_in %d, in0 %d, out %d, ws %zu); nothing launched\n", n_in, n_in > 0 ? in_sizes[0] : -1, out_size, ws_size); grid = -1; return; }
        int dev = 0, cus = 0, per_cu = 0;
        if (hipGetDevice(&dev) != hipSuccess || hipDeviceGetAttribute(&cus, hipDeviceAttributeMultiprocessorCount, dev) != hipSuccess) { grid = -1; return; }
        if (hipFuncSetAttribute((const void*)fwd_mega, hipFuncAttributeMaxDynamicSharedMemorySize, LDS_BYTES) != hipSuccess) { fprintf(stderr, "kernel_launch: hipFuncSetAttribute failed\n"); grid = -1; return; }
        if (hipOccupancyMaxActiveBlocksPerMultiprocessor(&per_cu, (const void*)fwd_mega, NWAVES * 64, LDS_BYTES) != hipSuccess || per_cu < 1) { fprintf(stderr, "kernel_launch: occupancy query says %d blocks per CU\n", per_cu); per_cu = 1; }
        (void)hipGetLastError();
        grid = cus;
        if (grid % 8 != 0) grid -= grid % 8;
    }
    if (grid <= 0) return;
    if (hipMemsetAsync((char*)d_ws + WS_CTL, 0, CTL_ZERO_BYTES, stream) != hipSuccess) { fprintf(stderr, "kernel_launch: hipMemsetAsync failed\n"); return; }
    Args a{};
    for (int i = 0; i < 23; ++i) a.in[i] = (const float*)d_in[i];
    a.out = (float*)d_out; a.ws = (unsigned char*)d_ws; a.ph_lo = 0; a.ph_hi = 1000;
    void* kargs[] = {&a};
    hipError_t e = hipLaunchCooperativeKernel((const void*)fwd_mega, dim3(grid), dim3(NWAVES * 64), kargs, LDS_BYTES, stream);
    if (e != hipSuccess) fprintf(stderr, "kernel_launch: cooperative launch failed: %s (grid %d)\n", hipGetErrorString(e), grid);
}
```
